# Optimizing an MI355X kernel written in HIP

```python
import jax, jax.numpy as jnp
from jax import lax
import numpy as np

D_MODEL = 2048
BATCH = 4
SEQ = 2048
DEPTH = 4
DEC_BATCH = 128
DEC_SEQ = 4
PAST_LEN = 16384
PAGE_SIZE = 128

D_MIX = D_MODEL
W_A = D_MIX // 2
W_B = D_MIX - W_A
HGRN_EXPAND = 128
H_A = W_A // HGRN_EXPAND
DK = HGRN_EXPAND
DV = W_A // H_A
CONV_W = 3
N_META = 16
CHUNK = 64
EPS = 1e-6
F_FLOOR = 1e-30
SPLITS = (W_A, W_A, W_A, W_A, W_B, W_B, W_B, W_B)
D_IN = sum(SPLITS)

kernel_name = "hymba_hgrn2_shortconv_decode_step"


def rmsnorm(x, w):
    xf = x.astype(jnp.float32)
    y = xf * lax.rsqrt(jnp.mean(xf * xf, axis=-1, keepdims=True) + EPS)
    return (y * w.astype(jnp.float32)).astype(x.dtype)


def hgrn_chunk(S, inp):
    q, k, g, v = inp
    L = q.shape[1]
    G = jnp.cumsum(g, axis=1)
    causal = jnp.tril(jnp.ones((L, L), dtype=bool))[None, :, :, None, None]
    diff = G[:, :, None] - G[:, None, :]
    decay = jnp.where(causal, jnp.exp(jnp.minimum(diff, 0.0)), 0.0)
    A = jnp.sum(q[:, :, None] * k[:, None] * decay, axis=-1)
    o = (jnp.einsum('btsh,bshv->bthv', A, v)
         + jnp.einsum('bthk,bhkv->bthv', q * jnp.exp(G), S))
    G_last = G[:, -1]
    S_new = (jnp.exp(G_last)[..., None] * S
             + jnp.einsum('bshk,bshv->bhkv', k * jnp.exp(G_last[:, None] - G), v))
    return S_new, o


def hgrn_prompt(q, k, g, v):
    Bn = q.shape[0]
    S0 = jnp.zeros((Bn, H_A, DK, DV), jnp.float32)
    S, o_meta = hgrn_chunk(S0, (q[:, :N_META], k[:, :N_META], g[:, :N_META], v[:, :N_META]))

    def to_chunks(a):
        r = a[:, N_META:]
        n = r.shape[1] // CHUNK
        return r.reshape(Bn, n, CHUNK, *r.shape[2:]).swapaxes(0, 1)

    S, o_rest = lax.scan(hgrn_chunk, S, (to_chunks(q), to_chunks(k), to_chunks(g), to_chunks(v)))
    o_rest = o_rest.swapaxes(0, 1).reshape(Bn, -1, H_A, DV)
    return jnp.concatenate([o_meta, o_rest], axis=1), S


def short_conv(u, buf, w):
    T = u.shape[1]
    pad = jnp.concatenate([buf.astype(u.dtype), u], axis=1)
    y = sum(w[j] * pad[:, j:j + T] for j in range(CONV_W))
    return y, pad[:, -(CONV_W - 1):]


def mixer_layer(h, l, S0, buf, prompt, w_in, conv_w, lb_param, hgrn_norm_w, w_out,
                pre_norm_w, post_norm_w):
    Bn, T, _ = h.shape
    hn = rmsnorm(h, pre_norm_w[l])
    proj = jnp.einsum('btd,de->bte', hn, w_in[l]).astype(jnp.float32)
    q, fz, i, za, bg, cg, xt, zb = jnp.split(proj, list(np.cumsum(SPLITS)[:-1]), axis=-1)

    lb_w = jax.nn.softmax(lb_param.astype(jnp.float32), axis=0)
    lb_all = jnp.cumsum(lb_w, axis=0) - lb_w[0]
    lb = lb_all[l].reshape(H_A, DK)
    fz = fz.reshape(Bn, T, H_A, DK)
    f = lb + (1.0 - lb) * jax.nn.sigmoid(fz)
    log_f = jnp.log(jnp.maximum(f, F_FLOOR))
    k = (1.0 - lb) * jax.nn.sigmoid(-fz)
    q = q.reshape(Bn, T, H_A, DK)
    v = i.reshape(Bn, T, H_A, DV)
    if prompt:
        o, S = hgrn_prompt(q, k, log_f, v)
    else:
        S, o = hgrn_chunk(S0.astype(jnp.float32), (q, k, log_f, v))
    o = rmsnorm(o, hgrn_norm_w[l]).reshape(Bn, T, W_A) * jax.nn.silu(za)

    if prompt:
        buf = jnp.zeros((Bn, CONV_W - 1, W_B), jnp.float32)
    c, new_buf = short_conv(cg * xt, buf, conv_w[l].astype(jnp.float32))
    yb = bg * c * jax.nn.silu(zb)

    mix = jnp.einsum('bte,ed->btd', jnp.concatenate([o, yb], axis=-1).astype(h.dtype), w_out[l])
    h = h + rmsnorm(mix, post_norm_w[l])
    return h, S, new_buf


def setup_inputs(seed: int = 0) -> dict:
    key = jax.random.key(seed)
    ks = jax.random.split(key, 12)
    f32 = jnp.float32
    return {
        "x_prompt": jax.random.normal(ks[0], (BATCH, SEQ, D_MODEL), f32),
        "x_sample": jax.random.normal(ks[1], (DEC_BATCH, DEC_SEQ, D_MODEL), f32),
        "state_hgrn": 0.5 * jax.random.normal(ks[2], (DEPTH, DEC_BATCH, H_A, DK, DV), f32),
        "state_conv": jax.random.normal(ks[3], (DEPTH, DEC_BATCH, CONV_W - 1, W_B), f32),
        "meta_tokens": jax.random.normal(ks[4], (N_META, D_MODEL), f32),
        "w_in": jax.random.normal(ks[5], (DEPTH, D_MODEL, D_IN), f32) * D_MODEL ** -0.5,
        "conv_w": jax.random.normal(ks[6], (DEPTH, CONV_W, W_B), f32) * CONV_W ** -0.5,
        "lb_param": 0.5 * jax.random.normal(ks[7], (DEPTH, H_A * DK), f32),
        "hgrn_norm_w": 1.0 + 0.02 * jax.random.normal(ks[8], (DEPTH, DV), f32),
        "w_out": jax.random.normal(ks[9], (DEPTH, D_MIX, D_MODEL), f32) * D_MIX ** -0.5,
        "pre_norm_w": 1.0 + 0.02 * jax.random.normal(ks[10], (DEPTH, D_MODEL), f32),
        "post_norm_w": 1.0 + 0.02 * jax.random.normal(ks[11], (DEPTH, D_MODEL), f32),
    }


def reference(x_prompt, x_sample, state_hgrn, state_conv, meta_tokens, w_in, conv_w, lb_param,
              hgrn_norm_w, w_out, pre_norm_w, post_norm_w):
    Bp = x_prompt.shape[0]
    meta = jnp.broadcast_to(meta_tokens[None].astype(x_prompt.dtype), (Bp, N_META, D_MODEL))
    hp = jnp.concatenate([meta, x_prompt], axis=1)
    hs = x_sample
    Sp_list, bp_list, Ss_list, bs_list = [], [], [], []
    for l in range(DEPTH):
        hp, Sp, bp = mixer_layer(hp, l, None, None, True, w_in, conv_w, lb_param, hgrn_norm_w,
                                 w_out, pre_norm_w, post_norm_w)
        hs, Ss, bs = mixer_layer(hs, l, state_hgrn[l], state_conv[l], False, w_in, conv_w,
                                 lb_param, hgrn_norm_w, w_out, pre_norm_w, post_norm_w)
        Sp_list.append(Sp.astype(x_prompt.dtype))
        bp_list.append(bp.astype(x_prompt.dtype))
        Ss_list.append(Ss.astype(state_hgrn.dtype))
        bs_list.append(bs.astype(state_conv.dtype))
    y_prompt = hp[:, N_META:]
    y_sample = hs
    new_hgrn_prompt = jnp.stack(Sp_list)
    new_conv_prompt = jnp.stack(bp_list)
    new_hgrn_sample = jnp.stack(Ss_list)
    new_conv_sample = jnp.stack(bs_list)
    return (y_prompt, y_sample, new_hgrn_prompt, new_conv_prompt, new_hgrn_sample, new_conv_sample)
```

```cpp
#include <hip/hip_runtime.h>
#include <cstdio>
#include <cstdint>
namespace pg8 {
#define PG8_LAS __attribute__((address_space(3)))
typedef unsigned short bf16_t;
typedef short bf16x8 __attribute__((ext_vector_type(8)));
typedef float f32x4 __attribute__((ext_vector_type(4)));
typedef unsigned u32x4 __attribute__((ext_vector_type(4)));
constexpr int BM = 256, BK = 64, HALF = 128, HTB = HALF * BK * 2  , STAGE_BYTES = 8 * HTB, NXCD = 8, WGM = 8;

__host__ __device__ __forceinline__ int lds_byte(int r, int c) { const int st = (r >> 4) * 2 + (c >> 5), rr = r & 15, cc = c & 31, ob = rr * 64 + cc * 2; return st * 1024 + (ob ^ (((ob >> 9) & 1) << 5)); }
__host__ __device__ __forceinline__ void stage_rc(int b, int& R, int& C) { const int st = b / 1024, sb = b % 1024, swz = sb ^ (((sb >> 9) & 1) << 5); R = (st >> 1) * 16 + swz / 64; C = (st & 1) * 32 + (swz % 64) / 2; }
__host__ __device__ __forceinline__ int perm32(int rho) { const int n = rho >> 4, i = rho & 15; return 8 * (i >> 2) + 4 * n + (i & 3); }

struct Unit { int pm, pn; };
struct Gemm { const bf16_t* A; const bf16_t* Bt; int M, N, K; };

struct StaticOrder {
    int nM, nN, nwg, G, c;
    __host__ __device__ void init(int M, int N, int G_, int c_) { nM = M / BM; nN = N / BM; nwg = nM * nN; G = G_; c = c_; }
    __host__ __device__ bool next(int i, Unit& u) const {
        const long L = (long)i * G + c; if (L >= nwg) return false;
        int wgid = (int)L; { const int q = nwg / NXCD, r = nwg % NXCD, xcd = wgid % NXCD, off = wgid / NXCD; wgid = (xcd < r ? xcd * (q + 1) : r * (q + 1) + (xcd - r) * q) + off; }
        const int nig = WGM * nN, gid = wgid / nig, fm = gid * WGM, gsz = (nM - fm) < WGM ? (nM - fm) : WGM;
        u.pm = fm + ((wgid % nig) % gsz); u.pn = (wgid % nig) / gsz; return true;
    }
    __device__ __forceinline__ void a_ready(const Unit&) const {}
    __device__ __forceinline__ void done(const Unit&) const {}
};

__device__ __forceinline__ unsigned cvt_pk_bf16(float lo, float hi) { unsigned r; asm volatile("v_cvt_pk_bf16_f32 %0, %1, %2" : "=v"(r) : "v"(lo), "v"(hi)); return r; }
typedef float f32x2 __attribute__((ext_vector_type(2)));
template <class Epi, class Sched, bool ALIGN_EPI = false, bool SP2 = false>
__device__ __forceinline__ void gemm_phase(PG8_LAS unsigned char* lds, const Gemm g, const Sched& S, const Epi& E) {
    int tid_ = threadIdx.x; asm volatile("" : "+v"(tid_));
    const int tid = tid_, wid = __builtin_amdgcn_readfirstlane(tid >> 6), lane = tid & 63, wr = wid >> 2, wc = wid & 3, fr = lane & 15, fq = lane >> 4;
    const int K = g.K, nt = K / BK;
    unsigned voffA[2], voffB[2];
#pragma unroll
    for (int i = 0; i < 2; ++i) { int R, C; stage_rc(tid * 16 + i * 8192, R, C); const int Rb = Epi::PERM ? ((R & ~31) + perm32(R & 31)) : R;
        voffA[i] = (unsigned)(R * K + C) * 2u; voffB[i] = (unsigned)(Rb * K + C) * 2u; }
    const size_t kstep = (size_t)(BK * 2);
    const size_t hstep = (size_t)HALF * K * 2;
    const size_t tstep = 2 * hstep;
    const unsigned ldsw = (unsigned)wid * 1024u;
    const int aoff = lds_byte(wr * 64 + fr, fq * 8), boff = lds_byte(wc * 32 + fr, fq * 8);
#define PG8_SA(b, h) (((b) * 2 + (h)) * HTB)
#define PG8_SB(b, h) ((4 + (b) * 2 + (h)) * HTB)
#define PG8_STAGE(bufoff, gbase, voff) do { _Pragma("unroll") for (int _i = 0; _i < 2; ++_i) \
        __builtin_amdgcn_global_load_lds((const unsigned*)((const char*)(gbase) + (voff)[_i]), (PG8_LAS unsigned*)(lds + (bufoff) + ldsw + _i * 8192), 16, 0, 0); } while (0)
#define PG8_LDA(dst, b, h) do { _Pragma("unroll") for (int m = 0; m < 4; ++m) _Pragma("unroll") for (int k = 0; k < 2; ++k) dst[m][k] = *(const PG8_LAS bf16x8*)(lds + PG8_SA(b, h) + aoff + m * 2048 + k * 1024); } while (0)
#define PG8_LDB(dst, b, h) do { _Pragma("unroll") for (int n = 0; n < 2; ++n) _Pragma("unroll") for (int k = 0; k < 2; ++k) dst[n][k] = *(const PG8_LAS bf16x8*)(lds + PG8_SB(b, h) + boff + n * 2048 + k * 1024); } while (0)
#define PG8_MMA(ai, bj, At, Bt) do { __builtin_amdgcn_s_setprio(1); _Pragma("unroll") for (int m = 0; m < 4; ++m) _Pragma("unroll") for (int n = 0; n < 2; ++n) _Pragma("unroll") for (int k = 0; k < 2; ++k) \
        acc[ai][bj][m][n] = __builtin_amdgcn_mfma_f32_16x16x32_bf16(Bt[n][k], At[m][k], acc[ai][bj][m][n], 0, 0, 0); __builtin_amdgcn_s_setprio(0); } while (0)
#define PG8_WAIT_V(n) asm volatile("s_waitcnt vmcnt(" #n ")" ::: "memory")
#define PG8_WAIT_L(n) asm volatile("s_waitcnt lgkmcnt(" #n ")" ::: "memory")
#define PG8_BAR __builtin_amdgcn_s_barrier()
#define PG8_SCHED __builtin_amdgcn_sched_barrier(0)
    Unit cur, nxt; int ui = 0;
    if (!S.next(0, cur)) return;
    f32x4 acc[2][2][4][2];
#pragma unroll
    for (int a = 0; a < 2; ++a)
#pragma unroll
        for (int b = 0; b < 2; ++b)
#pragma unroll
            for (int m = 0; m < 4; ++m)
#pragma unroll
                for (int n = 0; n < 2; ++n) acc[a][b][m][n] = (f32x4){0.f, 0.f, 0.f, 0.f};
    bf16x8 At[4][2], B0[2][2], B1[2][2];
    const char* cA = (const char*)g.A + (size_t)cur.pm * tstep; const char* cB = (const char*)g.Bt + (size_t)cur.pn * tstep;
    S.a_ready(cur);
    if constexpr (SP2) {
        PG8_STAGE(PG8_SB(0, 0), cB, voffB); PG8_STAGE(PG8_SB(0, 1), cB + hstep, voffB); PG8_STAGE(PG8_SA(0, 0), cA, voffA); PG8_STAGE(PG8_SA(0, 1), cA + hstep, voffA);
        if (wr == 1) PG8_BAR;
        PG8_WAIT_V(2); PG8_BAR;
        PG8_STAGE(PG8_SB(1, 0), cB + kstep, voffB); PG8_STAGE(PG8_SA(1, 0), cA + kstep, voffA); PG8_STAGE(PG8_SB(1, 1), cB + hstep + kstep, voffB);
        PG8_WAIT_V(6); PG8_BAR;
    } else {
        PG8_STAGE(PG8_SB(0, 0), cB, voffB); PG8_STAGE(PG8_SA(0, 0), cA, voffA); PG8_STAGE(PG8_SB(0, 1), cB + hstep, voffB); PG8_STAGE(PG8_SA(0, 1), cA + hstep, voffA);
        if (wr == 1) PG8_BAR;
        PG8_WAIT_V(4); PG8_BAR;
        PG8_STAGE(PG8_SB(1, 0), cB + kstep, voffB); PG8_STAGE(PG8_SA(1, 0), cA + kstep, voffA); PG8_STAGE(PG8_SB(1, 1), cB + hstep + kstep, voffB);
        PG8_WAIT_V(6); PG8_BAR;
    }
    for (;;) {
        const bool has_next = S.next(ui + 1, nxt);
        const char* nA = has_next ? (const char*)g.A + (size_t)nxt.pm * tstep : cA; const char* nB = has_next ? (const char*)g.Bt + (size_t)nxt.pn * tstep : cB;
        for (int t = 0; t < nt; t += 2) {
            const bool last = (t == nt - 2);
            const char* a1 = cA + (size_t)(t + 1) * kstep;
            const char* a2 = last ? nA : cA + (size_t)(t + 2) * kstep; const char* b2 = last ? nB : cB + (size_t)(t + 2) * kstep;
            const char* a3 = a2 + kstep; const char* b3 = b2 + kstep;
            if (last && has_next) S.a_ready(nxt);
            if constexpr (SP2) {
            PG8_LDB(B0, 0, 0); PG8_LDB(B1, 0, 1); PG8_SCHED; PG8_LDA(At, 0, 0); PG8_STAGE(PG8_SA(1, 1), a1 + hstep, voffA);
            PG8_WAIT_V(8); PG8_WAIT_L(0); PG8_BAR; PG8_MMA(0, 0, At, B0); PG8_MMA(0, 1, At, B1); PG8_BAR; PG8_SCHED;
            PG8_LDA(At, 0, 1); PG8_STAGE(PG8_SB(0, 0), b2, voffB); PG8_STAGE(PG8_SB(0, 1), b2 + hstep, voffB); PG8_STAGE(PG8_SA(0, 0), a2, voffA);
            PG8_WAIT_V(8); PG8_WAIT_L(0); PG8_BAR; PG8_MMA(1, 0, At, B0); PG8_MMA(1, 1, At, B1); PG8_BAR; PG8_SCHED;
            PG8_LDB(B0, 1, 0); PG8_LDB(B1, 1, 1); PG8_SCHED; PG8_LDA(At, 1, 0); PG8_STAGE(PG8_SA(0, 1), a2 + hstep, voffA);
            PG8_WAIT_V(8); PG8_WAIT_L(0); PG8_BAR; PG8_MMA(0, 0, At, B0); PG8_MMA(0, 1, At, B1); PG8_BAR; PG8_SCHED;
            PG8_LDA(At, 1, 1); PG8_STAGE(PG8_SB(1, 0), b3, voffB); PG8_STAGE(PG8_SB(1, 1), b3 + hstep, voffB); PG8_STAGE(PG8_SA(1, 0), a3, voffA);
            PG8_WAIT_V(8); PG8_WAIT_L(0); PG8_BAR; PG8_MMA(1, 0, At, B0); PG8_MMA(1, 1, At, B1); PG8_BAR; PG8_SCHED;
            } else {
            PG8_LDB(B0, 0, 0); PG8_SCHED; PG8_LDA(At, 0, 0); PG8_STAGE(PG8_SA(1, 1), a1 + hstep, voffA);
            PG8_WAIT_L(8); PG8_BAR; PG8_WAIT_L(0); PG8_MMA(0, 0, At, B0); PG8_BAR; PG8_SCHED;
            PG8_LDB(B1, 0, 1); PG8_STAGE(PG8_SB(0, 0), b2, voffB);
            PG8_BAR; PG8_WAIT_L(0); PG8_MMA(0, 1, At, B1); PG8_BAR;
            PG8_LDA(At, 0, 1); PG8_STAGE(PG8_SA(0, 0), a2, voffA);
            PG8_BAR; PG8_WAIT_L(0); PG8_MMA(1, 0, At, B0); PG8_BAR; PG8_SCHED;
            PG8_STAGE(PG8_SB(0, 1), b2 + hstep, voffB);
            PG8_WAIT_V(6); PG8_BAR; PG8_MMA(1, 1, At, B1); PG8_BAR;
            PG8_LDB(B0, 1, 0); PG8_SCHED; PG8_LDA(At, 1, 0); PG8_STAGE(PG8_SA(0, 1), a2 + hstep, voffA);
            PG8_WAIT_L(8); PG8_BAR; PG8_WAIT_L(0); PG8_MMA(0, 0, At, B0); PG8_BAR; PG8_SCHED;
            PG8_LDB(B1, 1, 1); PG8_STAGE(PG8_SB(1, 0), b3, voffB);
            PG8_BAR; PG8_WAIT_L(0); PG8_MMA(0, 1, At, B1); PG8_BAR;
            PG8_LDA(At, 1, 1); PG8_STAGE(PG8_SA(1, 0), a3, voffA);
            PG8_BAR; PG8_WAIT_L(0); PG8_MMA(1, 0, At, B0); PG8_BAR; PG8_SCHED;
            PG8_STAGE(PG8_SB(1, 1), b3 + hstep, voffB);
            PG8_WAIT_V(6); PG8_BAR; PG8_MMA(1, 1, At, B1); PG8_BAR;
            }
        }
        if constexpr (ALIGN_EPI) { if (wr == 0) PG8_BAR; }
        if constexpr (!Epi::AFTER_DRAIN) { E(acc, cur, wr, wc, fr, fq); S.done(cur); }
        if (!has_next) break;
#pragma unroll
        for (int a = 0; a < 2; ++a)
#pragma unroll
            for (int b = 0; b < 2; ++b)
#pragma unroll
                for (int m = 0; m < 4; ++m)
#pragma unroll
                    for (int n = 0; n < 2; ++n) acc[a][b][m][n] = (f32x4){0.f, 0.f, 0.f, 0.f};
        cur = nxt; cA = nA; cB = nB; ++ui;
        if constexpr (ALIGN_EPI) { if (wr == 1) PG8_BAR; }
    }
    PG8_WAIT_V(0);
    if constexpr (!ALIGN_EPI) { if (wr == 0) PG8_BAR; }
    PG8_BAR;
    if constexpr (Epi::AFTER_DRAIN) { E.fused(acc, cur, wr, wc, fr, fq, lds, wid, lane); S.done(cur); }
#undef PG8_SA
#undef PG8_SB
#undef PG8_STAGE
#undef PG8_LDA
#undef PG8_LDB
#undef PG8_MMA
#undef PG8_WAIT_V
#undef PG8_WAIT_L
#undef PG8_BAR
#undef PG8_SCHED
}
}

#define DI __device__ __forceinline__
#define GAS __attribute__((address_space(1)))
#define LAS __attribute__((address_space(3)))
typedef unsigned short bf16;
typedef unsigned v4u __attribute__((ext_vector_type(4)));
typedef unsigned v2u __attribute__((ext_vector_type(2)));
typedef float f32x4 __attribute__((ext_vector_type(4)));
typedef float f32x2 __attribute__((ext_vector_type(2)));

constexpr int NWAVES = 8, NTHR = 512;
constexpr int DM = 2048, DIN = 8192, WA = 1024, NH = 8, HD = 128, DEPTH = 4;
constexpr int BATCH = 4, SEQ = 2048, NMETA = 16, DECB = 128, DECT = 4;
constexpr int ROW_S0 = BATCH * SEQ;
constexpr int ROW_M0 = ROW_S0 + DECB * DECT;
constexpr int M_ROWS = ROW_M0 + BATCH * NMETA;
constexpr int M_PAD = 8960;
constexpr float EPS = 1e-6f;
constexpr int TPB = NMETA + SEQ;

constexpr size_t O_YP = 0, O_YS = O_YP + (size_t)BATCH * SEQ * DM, O_SHP = O_YS + (size_t)DECB * DECT * DM,
                 O_SCP = O_SHP + (size_t)DEPTH * BATCH * NH * HD * HD, O_SHS = O_SCP + (size_t)DEPTH * BATCH * 2 * WA,
                 O_SCS = O_SHS + (size_t)DEPTH * DECB * NH * HD * HD, O_END = O_SCS + (size_t)DEPTH * DECB * 2 * WA;

constexpr size_t MiB = 1u << 20;
constexpr size_t WS_CTL = 0, CTL_ZERO_BYTES = 64 * 1024;
constexpr size_t WS_LB = 1 * MiB;
constexpr size_t WS_WIN = 2 * MiB;
constexpr size_t WS_WOUT = WS_WIN + 128 * MiB;
constexpr size_t WS_H = WS_WOUT + 32 * MiB;
constexpr size_t WS_HN = WS_H + 70 * MiB;
constexpr size_t HALF35 = 35 * MiB / 2;
constexpr size_t WS_Q = WS_HN + 35 * MiB;
constexpr size_t WS_K1 = WS_Q + HALF35, WS_V = WS_K1 + HALF35, WS_ZA = WS_V + HALF35, WS_U = WS_ZA + HALF35, WS_GT = WS_U + HALF35;
constexpr size_t WS_G = WS_GT + HALF35;
constexpr size_t WS_X = WS_G + 35 * MiB;
constexpr size_t WS_MIX = WS_X + 35 * MiB;
constexpr size_t WS_END = WS_MIX + 70 * MiB;
constexpr int CW_BAR = 4096;

constexpr int RING_BYTES = 131072, LDSCTL_OFF = RING_BYTES, MISC_OFF = LDSCTL_OFF + 320, LDS_BYTES = 147456;

#define LDS_WAIT() asm volatile("s_waitcnt lgkmcnt(0)" ::: "memory")
#define VM_WAIT() asm volatile("s_waitcnt vmcnt(0)" ::: "memory")

DI float bf2f(unsigned short b) { return __uint_as_float(((unsigned)b) << 16); }
DI float bflo(unsigned w) { return __uint_as_float(w << 16); }
DI float bfhi(unsigned w) { return __uint_as_float(w & 0xffff0000u); }
DI unsigned pk2(float lo, float hi) { return pg8::cvt_pk_bf16(lo, hi); }
DI unsigned short f2bf1(float f) { return (unsigned short)(pk2(f, 0.f) & 0xffffu); }
DI float wave_sum(float v) {
#pragma unroll
    for (int o = 1; o < 64; o <<= 1) v += __shfl_xor(v, o);
    return v;
}
DI float fast_exp(float x) { return __expf(x); }
DI float sigmoidf(float x) { return __builtin_amdgcn_rcpf(1.0f + __expf(-x)); }
DI float siluf(float x) { return x * sigmoidf(x); }

#define XB_TMO      128
#define XB_XCNT(j)  (256  + 64 * (j))
#define XB_XSUB(j)  (1280 + 64 * (j))
#define XB_XGEN(j)  (2304 + 64 * (j))
#define XB_TOP      3328
#define XB_TOPGEN   3392
#define XCD_BAR_WORDS 3456
#define XB_SPIN_CAP (1u << 18)
DI unsigned xb_ld(unsigned* p)              { return __hip_atomic_load(p, __ATOMIC_RELAXED, __HIP_MEMORY_SCOPE_AGENT); }
DI unsigned xb_add(unsigned* p, unsigned v) { return __hip_atomic_fetch_add(p, v, __ATOMIC_RELAXED, __HIP_MEMORY_SCOPE_AGENT); }
DI unsigned xb_xcc_id() { return (unsigned)__builtin_amdgcn_s_getreg((3 << 11) | 20) & 0xFu; }
#define XB_SPIN(cond, bar) do { unsigned _sp = 0; while (cond) { __builtin_amdgcn_s_sleep(1); \
    if ((++_sp & 255u) == 0u) { if (xb_ld(&(bar)[XB_TMO])) break; if (_sp > XB_SPIN_CAP) { atomicAdd(&(bar)[XB_TMO], 1u); break; } } } } while (0)
struct XcdBarrier { unsigned* bar; unsigned x; volatile LAS unsigned* st; };
DI XcdBarrier xcd_barrier_post(unsigned* bar, volatile LAS unsigned* st) {
    XcdBarrier b; b.bar = bar; b.x = xb_xcc_id(); b.st = st;
    if (threadIdx.x == 0) (void)xb_add(&bar[XB_XCNT(b.x)], 1u);
    return b;
}
DI void xcd_barrier_complete(unsigned* bar, unsigned x, unsigned& nloc, unsigned& nx) {
    const unsigned G = gridDim.x * gridDim.y * gridDim.z;
    unsigned sum, cnt, mine, sp = 0u;
    for (;;) {
        sum = 0u; cnt = 0u; mine = 0u;
#pragma unroll
        for (unsigned j = 0; j < 16; ++j) { const unsigned c = xb_ld(&bar[XB_XCNT(j)]); sum += c; cnt += (c > 0u) ? 1u : 0u; mine = (j == x) ? c : mine; }
        if (sum == G) break;
        __builtin_amdgcn_s_sleep(1);
        if ((++sp & 255u) == 0u) { if (xb_ld(&bar[XB_TMO])) break; if (sp > XB_SPIN_CAP) { atomicAdd(&bar[XB_TMO], 1u); break; } }
    }
    nloc = mine > 0u ? mine : 1u; nx = cnt > 0u ? cnt : 1u;
}
DI void xcd_barrier(const XcdBarrier& b) {
    asm volatile("s_waitcnt vmcnt(0)" ::: "memory");
    __syncthreads();
    if (threadIdx.x == 0) {
        unsigned* bar = b.bar;
        __builtin_amdgcn_s_waitcnt(0);
        unsigned nloc = b.st[0], nx = b.st[1];
        if (nloc == 0u) { xcd_barrier_complete(bar, b.x, nloc, nx); b.st[0] = nloc; b.st[1] = nx; }
        const unsigned old = xb_add(&bar[XB_XSUB(b.x)], 1u);
        const unsigned gen = old / nloc;
        if (old + 1u == (gen + 1u) * nloc) {
            __builtin_amdgcn_fence(__ATOMIC_RELEASE, "agent");
            asm volatile("s_waitcnt vmcnt(0)" ::: "memory");
            const unsigned og = xb_add(&bar[XB_TOP], 1u);
            const unsigned tg = og / nx;
            if (og + 1u == (tg + 1u) * nx) xb_add(&bar[XB_TOPGEN], 1u);
            else XB_SPIN(xb_ld(&bar[XB_TOPGEN]) == tg, bar);
            __builtin_amdgcn_fence(__ATOMIC_ACQUIRE, "agent");
            xb_add(&bar[XB_XGEN(b.x)], 1u);
            asm volatile("s_waitcnt vmcnt(0)" ::: "memory");
        } else {
            XB_SPIN(xb_ld(&bar[XB_XGEN(b.x)]) == gen, bar);
            __builtin_amdgcn_fence(__ATOMIC_ACQUIRE, "agent");
            asm volatile("s_waitcnt vmcnt(0)" ::: "memory");
        }
    }
    __syncthreads();
}

struct Ctx {
    LAS unsigned char* lds;
    int vcu, G;
    const float *x_prompt, *x_sample, *state_hgrn, *state_conv, *meta, *w_in, *conv_w, *lb_param, *hgrn_nw, *w_out, *pre_w, *post_w;
    float* out;
    unsigned char* ws;
};
struct Tid { int tid, lane, wave; };
DI Tid get_tid() {
    int t = threadIdx.x; asm volatile("" : "+v"(t));
    Tid r; r.tid = t; r.lane = t & 63; r.wave = __builtin_amdgcn_readfirstlane(t >> 6); return r;
}
DI const float* in_row(const Ctx& c, int row) {
    if (row < ROW_S0) return c.x_prompt + (size_t)row * DM;
    if (row < ROW_M0) return c.x_sample + (size_t)(row - ROW_S0) * DM;
    return c.meta + (size_t)((row - ROW_M0) & (NMETA - 1)) * DM;
}
DI int prompt_row(int b, int p) { return p < NMETA ? ROW_M0 + b * NMETA + p : b * SEQ + (p - NMETA); }

DI int src_col_in(int np) {
    if (np < 4096) return np;
    const int pn = np >> 8, p = np & 255;
    const int s = 2 * (p >> 7) + ((p >> 2) & 1), wc = (p >> 5) & 3, fq = (p >> 3) & 3, j = p & 3;
    return 4096 + s * 1024 + (pn - 16) * 64 + 16 * wc + 4 * fq + j;
}

DI void transpose_item(const float* W, int K, int N, bf16* WT, LAS float* scr, int item, int lane, bool perm) {
    const int nblk = N / 32, kb = item / nblk, nb = item % nblk, k0 = 64 * kb, n0 = 32 * nb;
    const int np = n0 + (lane & 31);
    const int sc = perm ? src_col_in(np) : np;
#pragma unroll 8
    for (int i = 0; i < 32; ++i) { const int kk = 2 * i + (lane >> 5); scr[kk * 33 + (lane & 31)] = W[(size_t)(k0 + kk) * N + sc]; }
    LDS_WAIT();
    const int c = lane & 7;
#pragma unroll
    for (int j = 0; j < 4; ++j) { const int n = (lane >> 3) + 8 * j; const LAS float* s = scr + (8 * c) * 33 + n;
        v4u o; o.x = pk2(s[0 * 33], s[1 * 33]); o.y = pk2(s[2 * 33], s[3 * 33]); o.z = pk2(s[4 * 33], s[5 * 33]); o.w = pk2(s[6 * 33], s[7 * 33]);
        *(v4u*)(WT + (size_t)(n0 + n) * K + k0 + 8 * c) = o; }
    LDS_WAIT();
}
DI void phase_prep(const Ctx& c) {
    const Tid t_ = get_tid(); const int tid = t_.tid, lane = t_.lane, wave = t_.wave;
    LAS float* scr = (LAS float*)(c.lds + wave * 16384);
    const int gw = c.vcu * NWAVES + wave, NGW = c.G * NWAVES;
    constexpr int I_IN = (DM / 64) * (DIN / 32), I_OUT = (DM / 64) * (DM / 32);
    constexpr int NITEMS = DEPTH * (I_IN + I_OUT);
    for (int it = gw; it < NITEMS; it += NGW) {
        if (it < DEPTH * I_IN) { const int l = it / I_IN, r = it % I_IN;
            transpose_item(c.w_in + (size_t)l * DM * DIN, DM, DIN, (bf16*)(c.ws + WS_WIN) + (size_t)l * DIN * DM, scr, r, lane, true); }
        else { const int q = it - DEPTH * I_IN, l = q / I_OUT, r = q % I_OUT;
            transpose_item(c.w_out + (size_t)l * DM * DM, DM, DM, (bf16*)(c.ws + WS_WOUT) + (size_t)l * DM * DM, scr, r, lane, false); }
    }
    const int gt = c.vcu * NTHR + tid;
    if (gt < WA) {
        float p[DEPTH], mx = -3.0e38f;
#pragma unroll
        for (int l = 0; l < DEPTH; ++l) { p[l] = c.lb_param[l * WA + gt]; mx = fmaxf(mx, p[l]); }
        float s = 0.f;
#pragma unroll
        for (int l = 0; l < DEPTH; ++l) { p[l] = expf(p[l] - mx); s += p[l]; }
        float* LB = (float*)(c.ws + WS_LB); float cum = 0.f;
#pragma unroll
        for (int l = 0; l < DEPTH; ++l) { if (l > 0) cum += p[l] / s; LB[l * WA + gt] = cum; }
    }
}

DI void phase_norm(const Ctx& c, int l) {
    const Tid t_ = get_tid(); const int lane = t_.lane, wave = t_.wave;
    const int gw = c.vcu * NWAVES + wave, NGW = c.G * NWAVES;
    float* H = (float*)(c.ws + WS_H); const float* MIX = (const float*)(c.ws + WS_MIX); bf16* HN = (bf16*)(c.ws + WS_HN);
    for (int row = gw; row < M_ROWS; row += NGW) {
        const float* src = (l <= 1) ? in_row(c, row) : (const float*)(H + (size_t)row * DM);
        f32x4 h[8];
#pragma unroll
        for (int j = 0; j < 8; ++j) h[j] = ((const f32x4*)src)[lane + 64 * j];
        if (l >= 1) {
            const f32x4* mx = (const f32x4*)(MIX + (size_t)row * DM) + lane;
            f32x4 m[8]; float ss = 0.f;
#pragma unroll
            for (int j = 0; j < 8; ++j) { m[j] = mx[64 * j]; ss += (m[j].x * m[j].x + m[j].y * m[j].y) + (m[j].z * m[j].z + m[j].w * m[j].w); }
            const float r1 = 1.0f / sqrtf(wave_sum(ss) * (1.0f / DM) + EPS);
            const f32x4* wp = (const f32x4*)(c.post_w + (size_t)(l - 1) * DM) + lane;
#pragma unroll
            for (int j = 0; j < 8; ++j) h[j] = h[j] + m[j] * r1 * wp[64 * j];
        }
        if (l < DEPTH) {
            if (l >= 1) {
#pragma unroll
                for (int j = 0; j < 8; ++j) ((f32x4*)(H + (size_t)row * DM))[lane + 64 * j] = h[j];
            }
            float ss = 0.f;
#pragma unroll
            for (int j = 0; j < 8; ++j) ss += (h[j].x * h[j].x + h[j].y * h[j].y) + (h[j].z * h[j].z + h[j].w * h[j].w);
            const float r2 = 1.0f / sqrtf(wave_sum(ss) * (1.0f / DM) + EPS);
            const f32x4* wq = (const f32x4*)(c.pre_w + (size_t)l * DM) + lane;
            v2u* o8 = (v2u*)(HN + (size_t)row * DM) + lane;
#pragma unroll
            for (int j = 0; j < 8; ++j) { const f32x4 w = wq[64 * j]; const f32x4 v = h[j] * r2 * w; v2u o; o.x = pk2(v.x, v.y); o.y = pk2(v.z, v.w); o8[64 * j] = o; }
        } else {
            float* dst = row < ROW_S0 ? c.out + O_YP + (size_t)row * DM : (row < ROW_M0 ? c.out + O_YS + (size_t)(row - ROW_S0) * DM : nullptr);
            if (dst) {
#pragma unroll
                for (int j = 0; j < 8; ++j) ((f32x4*)dst)[lane + 64 * j] = h[j];
            }
        }
    }
}

namespace pg8 {
struct EpiInProj {
    static constexpr bool PERM = true, AFTER_DRAIN = false;
    unsigned char* ws; int l, pad_;
    __device__ __forceinline__ void operator()(const f32x4 (&acc)[2][2][4][2], const Unit& u, int wr, int wc, int fr, int fq) const {
        const int row0 = u.pm * BM + wr * 64 + fr, pn = u.pn;
        float* const G = (float*)(ws + WS_G); bf16_t* const K1 = (bf16_t*)(ws + WS_K1); bf16_t* const U = (bf16_t*)(ws + WS_U); bf16_t* const GT = (bf16_t*)(ws + WS_GT);
        const float* const lb = (const float*)(ws + WS_LB) + l * 1024;
        if (pn < 16) {
            const int seg = pn >> 2, col0 = (pn & 3) * 256 + wc * 32 + 8 * fq;
            if (seg == 1) {
                f32x4 lbv[2][2];
#pragma unroll
                for (int bj = 0; bj < 2; ++bj)
#pragma unroll
                    for (int n = 0; n < 2; ++n) lbv[bj][n] = *(const f32x4*)(lb + col0 + bj * HALF + 4 * n);
#pragma unroll
                for (int ai = 0; ai < 2; ++ai)
#pragma unroll
                    for (int m = 0; m < 4; ++m) { const size_t ro = (size_t)(row0 + ai * HALF + m * 16) * 1024 + col0;
#pragma unroll
                        for (int bj = 0; bj < 2; ++bj) { f32x4 gk[2], kk[2];
#pragma unroll
                            for (int n = 0; n < 2; ++n)
#pragma unroll
                                for (int e = 0; e < 4; ++e) { const float z = acc[ai][bj][m][n][e], lbe = lbv[bj][n][e];
                                    const float ez = __expf(-fabsf(z)), sp = __builtin_amdgcn_rcpf(1.0f + ez), sn = ez * sp;
                                    const float sg = z >= 0.f ? sp : sn, sm = z >= 0.f ? sn : sp;
                                    const float f = lbe + (1.0f - lbe) * sg;
                                    gk[n][e] = __logf(fmaxf(f, 1e-30f)); kk[n][e] = (1.0f - lbe) * sm; }
                            *(f32x4*)(G + ro + bj * HALF) = gk[0]; *(f32x4*)(G + ro + bj * HALF + 4) = gk[1];
                            u32x4 w; w.x = cvt_pk_bf16(kk[0][0], kk[0][1]); w.y = cvt_pk_bf16(kk[0][2], kk[0][3]); w.z = cvt_pk_bf16(kk[1][0], kk[1][1]); w.w = cvt_pk_bf16(kk[1][2], kk[1][3]);
                            *(u32x4*)(K1 + ro + bj * HALF) = w; } }
            } else {
                bf16_t* base = (bf16_t*)(ws + (seg == 0 ? WS_Q : (seg == 2 ? WS_V : WS_ZA)));
#pragma unroll
                for (int ai = 0; ai < 2; ++ai)
#pragma unroll
                    for (int m = 0; m < 4; ++m) { const size_t ro = (size_t)(row0 + ai * HALF + m * 16) * 1024 + col0;
#pragma unroll
                        for (int bj = 0; bj < 2; ++bj) { f32x4 v0 = acc[ai][bj][m][0], v1 = acc[ai][bj][m][1];
                            if (seg == 3) {
#pragma unroll
                                for (int e = 0; e < 4; ++e) { v0[e] = v0[e] * __builtin_amdgcn_rcpf(1.0f + __expf(-v0[e])); v1[e] = v1[e] * __builtin_amdgcn_rcpf(1.0f + __expf(-v1[e])); } }
                            u32x4 w; w.x = cvt_pk_bf16(v0[0], v0[1]); w.y = cvt_pk_bf16(v0[2], v0[3]); w.z = cvt_pk_bf16(v1[0], v1[1]); w.w = cvt_pk_bf16(v1[2], v1[3]);
                            *(u32x4*)(base + ro + bj * HALF) = w; } }
            }
        } else {
            const int ch0 = (pn - 16) * 64 + wc * 16 + fq * 4;
#pragma unroll
            for (int ai = 0; ai < 2; ++ai)
#pragma unroll
                for (int m = 0; m < 4; ++m) { const size_t ro = (size_t)(row0 + ai * HALF + m * 16) * 1024 + ch0;
                    const f32x4 bg = acc[ai][0][m][0], cg = acc[ai][0][m][1], xt = acc[ai][1][m][0], zb = acc[ai][1][m][1];
                    f32x4 uu = cg * xt, gt;
#pragma unroll
                    for (int e = 0; e < 4; ++e) gt[e] = bg[e] * zb[e] * __builtin_amdgcn_rcpf(1.0f + __expf(-zb[e]));
                    typedef unsigned u32x2 __attribute__((ext_vector_type(2)));
                    u32x2 a, b; a.x = cvt_pk_bf16(uu[0], uu[1]); a.y = cvt_pk_bf16(uu[2], uu[3]); b.x = cvt_pk_bf16(gt[0], gt[1]); b.y = cvt_pk_bf16(gt[2], gt[3]);
                    *(u32x2*)(U + ro) = a; *(u32x2*)(GT + ro) = b; }
        }
    }
};
struct EpiMix {
    static constexpr bool PERM = false, AFTER_DRAIN = false;
    float* C;
    __device__ __forceinline__ void operator()(const f32x4 (&acc)[2][2][4][2], const Unit& u, int wr, int wc, int fr, int fq) const {
        const int row0 = u.pm * BM + wr * 64 + fr, col0 = u.pn * BM + wc * 32 + 4 * fq;
#pragma unroll
        for (int ai = 0; ai < 2; ++ai)
#pragma unroll
            for (int m = 0; m < 4; ++m) { float* rowp = C + (size_t)(row0 + ai * HALF + m * 16) * 2048 + col0;
#pragma unroll
                for (int bj = 0; bj < 2; ++bj)
#pragma unroll
                    for (int n = 0; n < 2; ++n) *(f32x4*)(rowp + bj * HALF + n * 16) = acc[ai][bj][m][n]; }
    }
};
}

DI void phase_conv(const Ctx& c, int l) {
    const bf16* U = (const bf16*)(c.ws + WS_U); const bf16* GT = (const bf16*)(c.ws + WS_GT); bf16* X = (bf16*)(c.ws + WS_X);
    const Tid t_ = get_tid(); const int tid = t_.tid;
    const int sub = tid >> 7, ch0 = (tid & 127) * 8;
    const float* cw = c.conv_w + (size_t)l * 3 * WA + ch0;
    float w0[8], w1[8], w2[8];
#pragma unroll
    for (int e = 0; e < 8; ++e) { w0[e] = cw[e]; w1[e] = cw[WA + e]; w2[e] = cw[2 * WA + e]; }
    for (int row = c.vcu * 4 + sub; row < M_ROWS; row += c.G * 4) {
        int r1, r2, db = 0;
        if (row < ROW_S0) { const int b = row >> 11, t = row & (SEQ - 1);
            r1 = t >= 1 ? row - 1 : ROW_M0 + b * NMETA + 15;
            r2 = t >= 2 ? row - 2 : ROW_M0 + b * NMETA + 14 + t; }
        else if (row < ROW_M0) { const int idx = row - ROW_S0, j = idx & 3; db = idx >> 2;
            r1 = j >= 1 ? row - 1 : -2;
            r2 = j >= 2 ? row - 2 : (j == 1 ? -2 : -3); }
        else { const int m = (row - ROW_M0) & 15;
            r1 = m >= 1 ? row - 1 : -1;
            r2 = m >= 2 ? row - 2 : -1; }
        float u0[8], u1[8], u2[8];
        { const v4u w = *(const v4u*)(U + (size_t)row * WA + ch0);
          u0[0] = bflo(w.x); u0[1] = bfhi(w.x); u0[2] = bflo(w.y); u0[3] = bfhi(w.y); u0[4] = bflo(w.z); u0[5] = bfhi(w.z); u0[6] = bflo(w.w); u0[7] = bfhi(w.w); }
#pragma unroll
        for (int which = 0; which < 2; ++which) {
            const int r = which == 0 ? r1 : r2; float* d = which == 0 ? u1 : u2;
            if (r >= 0) { const v4u w = *(const v4u*)(U + (size_t)r * WA + ch0);
                d[0] = bflo(w.x); d[1] = bfhi(w.x); d[2] = bflo(w.y); d[3] = bfhi(w.y); d[4] = bflo(w.z); d[5] = bfhi(w.z); d[6] = bflo(w.w); d[7] = bfhi(w.w); }
            else if (r == -1) {
#pragma unroll
                for (int e = 0; e < 8; ++e) d[e] = 0.f; }
            else { const float* sc = c.state_conv + (((size_t)l * DECB + db) * 2 + (r == -2 ? 1 : 0)) * WA + ch0;
#pragma unroll
                for (int e = 0; e < 8; ++e) d[e] = sc[e]; }
        }
        const v4u gw = *(const v4u*)(GT + (size_t)row * WA + ch0);
        float g[8] = {bflo(gw.x), bfhi(gw.x), bflo(gw.y), bfhi(gw.y), bflo(gw.z), bfhi(gw.z), bflo(gw.w), bfhi(gw.w)};
        float y[8];
#pragma unroll
        for (int e = 0; e < 8; ++e) y[e] = g[e] * (w0[e] * u2[e] + w1[e] * u1[e] + w2[e] * u0[e]);
        v4u o; o.x = pk2(y[0], y[1]); o.y = pk2(y[2], y[3]); o.z = pk2(y[4], y[5]); o.w = pk2(y[6], y[7]);
        *(v4u*)(X + (size_t)row * DM + WA + ch0) = o;
        float* so = nullptr;
        if (row < ROW_S0) { const int b = row >> 11, t = row & (SEQ - 1); if (t >= SEQ - 2) so = c.out + O_SCP + (((size_t)l * BATCH + b) * 2 + (t - (SEQ - 2))) * WA + ch0; }
        else if (row < ROW_M0) { const int idx = row - ROW_S0, j = idx & 3; if (j >= 2) so = c.out + O_SCS + (((size_t)l * DECB + (idx >> 2)) * 2 + (j - 2)) * WA + ch0; }
        if (so) { *(f32x4*)so = (f32x4){u0[0], u0[1], u0[2], u0[3]}; *(f32x4*)(so + 4) = (f32x4){u0[4], u0[5], u0[6], u0[7]}; }
    }
}

DI void hgrn_sample_item(const Ctx& c, int l, int item) {
    const int db = item >> 3, h = item & 7, hc = h * HD; const Tid t_ = get_tid(); const int tid = t_.tid, lane = t_.lane, wave = t_.wave;
    LAS float* sQ = (LAS float*)c.lds;
    LAS float* sG = sQ + 512; LAS float* sK = sG + 512; LAS float* sV = sK + 512; LAS float* sZ = sV + 512;
    LAS float* sQE = sZ + 512; LAS float* sKH = sQE + 512; LAS float* sD = sKH + 512;
    LAS float* sA = sD + 128;
    LAS float* sSS = sA + 16;
    LAS float* sRed = sSS + 16;
    const bf16* Q = (const bf16*)(c.ws + WS_Q); const bf16* K1 = (const bf16*)(c.ws + WS_K1); const bf16* V = (const bf16*)(c.ws + WS_V); const bf16* ZA = (const bf16*)(c.ws + WS_ZA);
    const float* G = (const float*)(c.ws + WS_G); bf16* X = (bf16*)(c.ws + WS_X);
    const int row0 = ROW_S0 + db * DECT;
    { const int j = tid >> 7, cc = tid & 127; const size_t o = (size_t)(row0 + j) * WA + hc + cc;
      sQ[tid] = bf2f(Q[o]); sG[tid] = G[o]; sK[tid] = bf2f(K1[o]); sV[tid] = bf2f(V[o]); sZ[tid] = bf2f(ZA[o]); }
    const int kr = tid >> 5, v4 = tid & 31;
    const float* S0 = c.state_hgrn + (((size_t)l * DECB + db) * NH + h) * (size_t)(HD * HD);
    float* S1 = c.out + O_SHS + (((size_t)l * DECB + db) * NH + h) * (size_t)(HD * HD);
    f32x4 s[8];
#pragma unroll
    for (int i = 0; i < 8; ++i) s[i] = *(const f32x4*)(S0 + (size_t)(kr + 16 * i) * HD + 4 * v4);
    __syncthreads();
    if (tid < 128) {
        const float g0 = sG[tid], g1 = g0 + sG[128 + tid], g2 = g1 + sG[256 + tid], g3 = g2 + sG[384 + tid];
        sG[tid] = g0; sG[128 + tid] = g1; sG[256 + tid] = g2; sG[384 + tid] = g3;
        sQE[tid] = sQ[tid] * __expf(g0); sQE[128 + tid] = sQ[128 + tid] * __expf(g1); sQE[256 + tid] = sQ[256 + tid] * __expf(g2); sQE[384 + tid] = sQ[384 + tid] * __expf(g3);
        sKH[tid] = sK[tid] * __expf(g3 - g0); sKH[128 + tid] = sK[128 + tid] * __expf(g3 - g1); sKH[256 + tid] = sK[256 + tid] * __expf(g3 - g2); sKH[384 + tid] = sK[384 + tid];
        sD[tid] = __expf(g3);
    }
    __syncthreads();
    for (int p = wave; p < 10; p += NWAVES) {
        int t = 0, s2 = p; if (p >= 6) { t = 3; s2 = p - 6; } else if (p >= 3) { t = 2; s2 = p - 3; } else if (p >= 1) { t = 1; s2 = p - 1; }
        float a = 0.f;
#pragma unroll
        for (int q = 0; q < 2; ++q) { const int k = lane + 64 * q; a += sQ[t * 128 + k] * sK[s2 * 128 + k] * __expf(sG[t * 128 + k] - sG[s2 * 128 + k]); }
        a = wave_sum(a);
        if (lane == 0) sA[t * 4 + s2] = a;
    }
    f32x4 op[4];
#pragma unroll
    for (int t = 0; t < 4; ++t) op[t] = (f32x4){0.f, 0.f, 0.f, 0.f};
    f32x4 vv[4];
#pragma unroll
    for (int t = 0; t < 4; ++t) vv[t] = *(const LAS f32x4*)(sV + t * 128 + 4 * v4);
#pragma unroll
    for (int i = 0; i < 8; ++i) { const int k = kr + 16 * i;
        const f32x4 s0 = s[i];
#pragma unroll
        for (int t = 0; t < 4; ++t) op[t] = op[t] + s0 * sQE[t * 128 + k];
        f32x4 sn = s0 * sD[k];
#pragma unroll
        for (int t = 0; t < 4; ++t) sn = sn + vv[t] * sKH[t * 128 + k];
        *(f32x4*)(S1 + (size_t)k * HD + 4 * v4) = sn; }
#pragma unroll
    for (int t = 0; t < 4; ++t) {
#pragma unroll
        for (int e = 0; e < 4; ++e) op[t][e] += __shfl_xor(op[t][e], 32);
        if (lane < 32) *(LAS f32x4*)(sRed + (wave * 4 + t) * 128 + 4 * v4) = op[t]; }
    __syncthreads();
    { const int t = tid >> 7, v = tid & 127; float o = 0.f;
#pragma unroll
      for (int w = 0; w < NWAVES; ++w) o += sRed[(w * 4 + t) * 128 + v];
      for (int s2 = 0; s2 <= t; ++s2) o += sA[t * 4 + s2] * sV[s2 * 128 + v];
      const float ss = wave_sum(o * o);
      if (lane == 0) sSS[wave] = ss;
      __syncthreads();
      const float tot = sSS[2 * t] + sSS[2 * t + 1];
      const float r = 1.0f / sqrtf(tot * (1.0f / HD) + EPS);
      X[(size_t)(row0 + t) * DM + hc + v] = f2bf1(o * r * c.hgrn_nw[l * HD + v] * sZ[t * 128 + v]); }
    __syncthreads();
}

DI void hgrn_prompt_simple(const Ctx& c, int l, int item) {
    const int b = item >> 3, h = item & 7, hc = h * HD; const Tid t_ = get_tid(); const int tid = t_.tid, lane = t_.lane, wave = t_.wave;
    constexpr int TB = 8;
    LAS float* sF = (LAS float*)c.lds;
    LAS float* sK = sF + TB * 128; LAS float* sQ = sK + TB * 128; LAS float* sV = sQ + TB * 128; LAS float* sZ = sV + TB * 128;
    LAS float* sRed = sZ + TB * 128;
    const bf16* Q = (const bf16*)(c.ws + WS_Q); const bf16* K1 = (const bf16*)(c.ws + WS_K1); const bf16* V = (const bf16*)(c.ws + WS_V); const bf16* ZA = (const bf16*)(c.ws + WS_ZA);
    const float* G = (const float*)(c.ws + WS_G); bf16* X = (bf16*)(c.ws + WS_X);
    const int kr = tid >> 5, v4 = tid & 31;
    f32x4 S[8];
#pragma unroll
    for (int i = 0; i < 8; ++i) S[i] = (f32x4){0.f, 0.f, 0.f, 0.f};
    for (int p0 = 0; p0 < TPB; p0 += TB) {
#pragma unroll
        for (int i = 0; i < (5 * TB * 128) / NTHR; ++i) { const int e = tid + NTHR * i, arr = e / (TB * 128), tok = (e % (TB * 128)) >> 7, cc = e & 127;
            const size_t o = (size_t)prompt_row(b, p0 + tok) * WA + hc + cc; float val;
            if (arr == 0) val = __expf(G[o]); else if (arr == 1) val = bf2f(K1[o]); else if (arr == 2) val = bf2f(Q[o]); else if (arr == 3) val = bf2f(V[o]); else val = bf2f(ZA[o]);
            sF[e] = val; }
        __syncthreads();
#pragma unroll 2
        for (int tok = 0; tok < TB; ++tok) {
            const f32x4 vv = *(const LAS f32x4*)(sV + tok * 128 + 4 * v4);
            f32x4 op = (f32x4){0.f, 0.f, 0.f, 0.f};
#pragma unroll
            for (int i = 0; i < 8; ++i) { const int k = kr + 16 * i;
                S[i] = S[i] * sF[tok * 128 + k] + vv * sK[tok * 128 + k];
                op = op + S[i] * sQ[tok * 128 + k]; }
#pragma unroll
            for (int e = 0; e < 4; ++e) op[e] += __shfl_xor(op[e], 32);
            if (lane < 32) *(LAS f32x4*)(sRed + (tok * NWAVES + wave) * 128 + 4 * v4) = op;
        }
        __syncthreads();
        { const int tok = wave;
          float o0 = 0.f, o1 = 0.f;
#pragma unroll
          for (int w = 0; w < NWAVES; ++w) { o0 += sRed[(tok * NWAVES + w) * 128 + lane]; o1 += sRed[(tok * NWAVES + w) * 128 + 64 + lane]; }
          const float ss = wave_sum(o0 * o0 + o1 * o1);
          const float r = 1.0f / sqrtf(ss * (1.0f / HD) + EPS);
          const size_t xo = (size_t)prompt_row(b, p0 + tok) * DM + hc;
          X[xo + lane] = f2bf1(o0 * r * c.hgrn_nw[l * HD + lane] * sZ[tok * 128 + lane]);
          X[xo + 64 + lane] = f2bf1(o1 * r * c.hgrn_nw[l * HD + 64 + lane] * sZ[tok * 128 + 64 + lane]); }
        __syncthreads();
    }
    float* So = c.out + O_SHP + (((size_t)l * BATCH + b) * NH + h) * (size_t)(HD * HD);
#pragma unroll
    for (int i = 0; i < 8; ++i) *(f32x4*)(So + (size_t)(kr + 16 * i) * HD + 4 * v4) = S[i];
}

DI void phase_mixer_simple(const Ctx& c, int l) {
    if (c.vcu < BATCH * NH) hgrn_prompt_simple(c, l, c.vcu);
    for (int it = c.vcu; it < DECB * NH; it += c.G) hgrn_sample_item(c, l, it);
    phase_conv(c, l);
}

struct Args { const float* in[12]; float* out; unsigned char* ws; int ph_lo, ph_hi; };
constexpr int N_PHASES = 1 + 5 * DEPTH;
__global__ void __launch_bounds__(NTHR, 2) fwd(Args args) {
    extern __shared__ __attribute__((aligned(16))) unsigned char lds_raw[];
    Ctx c;
    c.lds = (LAS unsigned char*)lds_raw;
    c.G = gridDim.x; { const int bx = blockIdx.x; c.vcu = (c.G % 8 == 0) ? (bx % 8) * (c.G / 8) + bx / 8 : bx; }
    c.x_prompt = args.in[0]; c.x_sample = args.in[1]; c.state_hgrn = args.in[2]; c.state_conv = args.in[3]; c.meta = args.in[4]; c.w_in = args.in[5];
    c.conv_w = args.in[6]; c.lb_param = args.in[7]; c.hgrn_nw = args.in[8]; c.w_out = args.in[9]; c.pre_w = args.in[10]; c.post_w = args.in[11];
    c.out = args.out; c.ws = args.ws;
    volatile LAS unsigned* MISC = (volatile LAS unsigned*)(c.lds + MISC_OFF);
    for (int u = threadIdx.x; u < (LDS_BYTES - LDSCTL_OFF) / 4; u += NTHR) ((LAS unsigned*)(c.lds + LDSCTL_OFF))[u] = 0u;
    __syncthreads();
    unsigned* barw = (unsigned*)(c.ws + WS_CTL) + CW_BAR;
    const bool multi = (args.ph_hi - args.ph_lo) > 1;
    XcdBarrier bar; bar.bar = barw; bar.x = 0; bar.st = nullptr;
    if (multi) bar = xcd_barrier_post(barw, MISC + 8);

    for (int ph = args.ph_lo; ph < args.ph_hi; ++ph) {
        if (ph > args.ph_lo) xcd_barrier(bar);
        if (ph == 0) { phase_prep(c); phase_norm(c, 0); continue; }
        const int l = (ph - 1) / 5, k = (ph - 1) % 5;
        if (k == 0) {
            pg8::Gemm g{(const pg8::bf16_t*)(c.ws + WS_HN), (const pg8::bf16_t*)(c.ws + WS_WIN) + (size_t)l * DIN * DM, M_PAD, DIN, DM};
            pg8::StaticOrder S; S.init(M_PAD, DIN, c.G, (int)blockIdx.x);
            pg8::EpiInProj E{c.ws, l, 0};
            pg8::gemm_phase<pg8::EpiInProj, pg8::StaticOrder, true, true>(c.lds, g, S, E);
        } else if (k == 1) {
        } else if (k == 2) {
            phase_mixer_simple(c, l);
        } else if (k == 3) {
            pg8::Gemm g{(const pg8::bf16_t*)(c.ws + WS_X), (const pg8::bf16_t*)(c.ws + WS_WOUT) + (size_t)l * DM * DM, M_PAD, DM, DM};
            pg8::StaticOrder S; S.init(M_PAD, DM, c.G, (int)blockIdx.x);
            pg8::EpiMix E{(float*)(c.ws + WS_MIX)};
            pg8::gemm_phase<pg8::EpiMix, pg8::StaticOrder, true, true>(c.lds, g, S, E);
        } else {
            phase_norm(c, l + 1);
        }
    }
}

#ifndef MK_MULTI
#define MK_MULTI 1
#endif
extern "C" void kernel_launch(void* const* d_in, const int* in_sizes, int n_in, void* d_out, int out_size, void* d_ws, size_t ws_size, hipStream_t stream) {
    static int grid = 0;
    if (grid == 0) {
        if (n_in != 12 || (size_t)out_size != O_END || ws_size < WS_END) { fprintf(stderr, "kernel_launch: unexpected shapes: n_in %d out %d ws %zu (need out %zu ws %zu)\n", n_in, out_size, ws_size, (size_t)O_END, (size_t)WS_END); grid = -1; return; }
        int dev = 0, cus = 0, per_cu = 0;
        if (hipGetDevice(&dev) != hipSuccess || hipDeviceGetAttribute(&cus, hipDeviceAttributeMultiprocessorCount, dev) != hipSuccess) { grid = -1; return; }
        if (hipFuncSetAttribute((const void*)fwd, hipFuncAttributeMaxDynamicSharedMemorySize, LDS_BYTES) != hipSuccess) { fprintf(stderr, "kernel_launch: hipFuncSetAttribute failed\n"); grid = -1; return; }
        if (hipOccupancyMaxActiveBlocksPerMultiprocessor(&per_cu, (const void*)fwd, NTHR, LDS_BYTES) != hipSuccess || per_cu < 1) { fprintf(stderr, "kernel_launch: occupancy query says %d blocks per CU\n", per_cu); (void)hipGetLastError(); per_cu = 1; }
        grid = cus;
    }
    if (grid < 0) return;
    (void)hipMemsetAsync((char*)d_ws + WS_CTL, 0, CTL_ZERO_BYTES, stream);
    Args a{};
    for (int i = 0; i < 12; ++i) a.in[i] = (const float*)d_in[i];
    a.out = (float*)d_out; a.ws = (unsigned char*)d_ws;
#if MK_MULTI
    for (int ph = 0; ph < N_PHASES; ++ph) {
        if (ph >= 1 && (ph - 1) % 5 == 1) continue;
        a.ph_lo = ph; a.ph_hi = ph + 1;
        hipLaunchKernelGGL(fwd, dim3(grid), dim3(NTHR), LDS_BYTES, stream, a);
    }
#else
    a.ph_lo = 0; a.ph_hi = N_PHASES;
    hipLaunchKernelGGL(fwd, dim3(grid), dim3(NTHR), LDS_BYTES, stream, a);
#endif
}
```

```cpp
#include <hip/hip_runtime.h>
#include <cstdio>
#include <cstdint>
namespace pg8 {
#define PG8_LAS __attribute__((address_space(3)))
typedef unsigned short bf16_t;
typedef short bf16x8 __attribute__((ext_vector_type(8)));
typedef float f32x4 __attribute__((ext_vector_type(4)));
typedef unsigned u32x4 __attribute__((ext_vector_type(4)));
constexpr int BM = 256, BK = 64, HALF = 128, HTB = HALF * BK * 2  , STAGE_BYTES = 8 * HTB, NXCD = 8, WGM = 8;

__host__ __device__ __forceinline__ int lds_byte(int r, int c) { const int st = (r >> 4) * 2 + (c >> 5), rr = r & 15, cc = c & 31, ob = rr * 64 + cc * 2; return st * 1024 + (ob ^ (((ob >> 9) & 1) << 5)); }
__host__ __device__ __forceinline__ void stage_rc(int b, int& R, int& C) { const int st = b / 1024, sb = b % 1024, swz = sb ^ (((sb >> 9) & 1) << 5); R = (st >> 1) * 16 + swz / 64; C = (st & 1) * 32 + (swz % 64) / 2; }
__host__ __device__ __forceinline__ int perm32(int rho) { const int n = rho >> 4, i = rho & 15; return 8 * (i >> 2) + 4 * n + (i & 3); }

struct Unit { int pm, pn; };
struct Gemm { const bf16_t* A; const bf16_t* Bt; int M, N, K, ld; };

struct StaticOrder {
    int nM, nN, nwg, G, c;
    __host__ __device__ void init(int M, int N, int G_, int c_) { nM = M / BM; nN = N / BM; nwg = nM * nN; G = G_; c = c_; }
    __host__ __device__ bool next(int i, Unit& u) const {
        const long L = (long)i * G + c; if (L >= nwg) return false;
        int wgid = (int)L; { const int q = nwg / NXCD, r = nwg % NXCD, xcd = wgid % NXCD, off = wgid / NXCD; wgid = (xcd < r ? xcd * (q + 1) : r * (q + 1) + (xcd - r) * q) + off; }
        const int nig = WGM * nN, gid = wgid / nig, fm = gid * WGM, gsz = (nM - fm) < WGM ? (nM - fm) : WGM;
        u.pm = fm + ((wgid % nig) % gsz); u.pn = (wgid % nig) / gsz; return true;
    }
    __device__ __forceinline__ void a_ready(const Unit&) const {}
    __device__ __forceinline__ void done(const Unit&) const {}
};

__device__ __forceinline__ unsigned cvt_pk_bf16(float lo, float hi) { unsigned r; asm volatile("v_cvt_pk_bf16_f32 %0, %1, %2" : "=v"(r) : "v"(lo), "v"(hi)); return r; }
typedef float f32x2 __attribute__((ext_vector_type(2)));
template <class Epi, class Sched, bool ALIGN_EPI = false, bool SP2 = false>
__device__ __forceinline__ void gemm_phase(PG8_LAS unsigned char* lds, const Gemm g, const Sched& S, const Epi& E) {
    int tid_ = threadIdx.x; asm volatile("" : "+v"(tid_));
    const int tid = tid_, wid = __builtin_amdgcn_readfirstlane(tid >> 6), lane = tid & 63, wr = wid >> 2, wc = wid & 3, fr = lane & 15, fq = lane >> 4;
    const int K = g.ld, nt = g.K / BK;
    unsigned voffA[2], voffB[2];
#pragma unroll
    for (int i = 0; i < 2; ++i) { int R, C; stage_rc(tid * 16 + i * 8192, R, C); const int Rb = Epi::PERM ? ((R & ~31) + perm32(R & 31)) : R;
        voffA[i] = (unsigned)(R * K + C) * 2u; voffB[i] = (unsigned)(Rb * K + C) * 2u; }
    const size_t kstep = (size_t)(BK * 2);
    const size_t hstep = (size_t)HALF * K * 2;
    const size_t tstep = 2 * hstep;
    const unsigned ldsw = (unsigned)wid * 1024u;
    const int aoff = lds_byte(wr * 64 + fr, fq * 8), boff = lds_byte(wc * 32 + fr, fq * 8);
#define PG8_SA(b, h) (((b) * 2 + (h)) * HTB)
#define PG8_SB(b, h) ((4 + (b) * 2 + (h)) * HTB)
#define PG8_STAGE(bufoff, gbase, voff) do { _Pragma("unroll") for (int _i = 0; _i < 2; ++_i) \
        __builtin_amdgcn_global_load_lds((const unsigned*)((const char*)(gbase) + (voff)[_i]), (PG8_LAS unsigned*)(lds + (bufoff) + ldsw + _i * 8192), 16, 0, 0); } while (0)
#define PG8_LDA(dst, b, h) do { _Pragma("unroll") for (int m = 0; m < 4; ++m) _Pragma("unroll") for (int k = 0; k < 2; ++k) dst[m][k] = *(const PG8_LAS bf16x8*)(lds + PG8_SA(b, h) + aoff + m * 2048 + k * 1024); } while (0)
#define PG8_LDB(dst, b, h) do { _Pragma("unroll") for (int n = 0; n < 2; ++n) _Pragma("unroll") for (int k = 0; k < 2; ++k) dst[n][k] = *(const PG8_LAS bf16x8*)(lds + PG8_SB(b, h) + boff + n * 2048 + k * 1024); } while (0)
#define PG8_MMA(ai, bj, At, Bt) do { __builtin_amdgcn_s_setprio(1); _Pragma("unroll") for (int m = 0; m < 4; ++m) _Pragma("unroll") for (int n = 0; n < 2; ++n) _Pragma("unroll") for (int k = 0; k < 2; ++k) \
        acc[ai][bj][m][n] = __builtin_amdgcn_mfma_f32_16x16x32_bf16(Bt[n][k], At[m][k], acc[ai][bj][m][n], 0, 0, 0); __builtin_amdgcn_s_setprio(0); } while (0)
#define PG8_WAIT_V(n) asm volatile("s_waitcnt vmcnt(" #n ")" ::: "memory")
#define PG8_WAIT_L(n) asm volatile("s_waitcnt lgkmcnt(" #n ")" ::: "memory")
#define PG8_BAR __builtin_amdgcn_s_barrier()
#define PG8_SCHED __builtin_amdgcn_sched_barrier(0)
    Unit cur, nxt; int ui = 0;
    if (!S.next(0, cur)) return;
    f32x4 acc[2][2][4][2];
#pragma unroll
    for (int a = 0; a < 2; ++a)
#pragma unroll
        for (int b = 0; b < 2; ++b)
#pragma unroll
            for (int m = 0; m < 4; ++m)
#pragma unroll
                for (int n = 0; n < 2; ++n) acc[a][b][m][n] = (f32x4){0.f, 0.f, 0.f, 0.f};
    bf16x8 At[4][2], B0[2][2], B1[2][2];
    const char* cA = (const char*)g.A + (size_t)cur.pm * tstep; const char* cB = (const char*)g.Bt + (size_t)cur.pn * tstep;
    S.a_ready(cur);
    if constexpr (SP2) {
        PG8_STAGE(PG8_SB(0, 0), cB, voffB); PG8_STAGE(PG8_SB(0, 1), cB + hstep, voffB); PG8_STAGE(PG8_SA(0, 0), cA, voffA); PG8_STAGE(PG8_SA(0, 1), cA + hstep, voffA);
        if (wr == 1) PG8_BAR;
        PG8_WAIT_V(2); PG8_BAR;
        PG8_STAGE(PG8_SB(1, 0), cB + kstep, voffB); PG8_STAGE(PG8_SA(1, 0), cA + kstep, voffA); PG8_STAGE(PG8_SB(1, 1), cB + hstep + kstep, voffB);
        PG8_WAIT_V(6); PG8_BAR;
    } else {
        PG8_STAGE(PG8_SB(0, 0), cB, voffB); PG8_STAGE(PG8_SA(0, 0), cA, voffA); PG8_STAGE(PG8_SB(0, 1), cB + hstep, voffB); PG8_STAGE(PG8_SA(0, 1), cA + hstep, voffA);
        if (wr == 1) PG8_BAR;
        PG8_WAIT_V(4); PG8_BAR;
        PG8_STAGE(PG8_SB(1, 0), cB + kstep, voffB); PG8_STAGE(PG8_SA(1, 0), cA + kstep, voffA); PG8_STAGE(PG8_SB(1, 1), cB + hstep + kstep, voffB);
        PG8_WAIT_V(6); PG8_BAR;
    }
    for (;;) {
        const bool has_next = S.next(ui + 1, nxt);
        const char* nA = has_next ? (const char*)g.A + (size_t)nxt.pm * tstep : cA; const char* nB = has_next ? (const char*)g.Bt + (size_t)nxt.pn * tstep : cB;
        for (int t = 0; t < nt; t += 2) {
            const bool last = (t == nt - 2);
            const char* a1 = cA + (size_t)(t + 1) * kstep;
            const char* a2 = last ? nA : cA + (size_t)(t + 2) * kstep; const char* b2 = last ? nB : cB + (size_t)(t + 2) * kstep;
            const char* a3 = a2 + kstep; const char* b3 = b2 + kstep;
            if (last && has_next) S.a_ready(nxt);
            if constexpr (SP2) {
            PG8_LDB(B0, 0, 0); PG8_LDB(B1, 0, 1); PG8_SCHED; PG8_LDA(At, 0, 0); PG8_STAGE(PG8_SA(1, 1), a1 + hstep, voffA);
            PG8_WAIT_V(8); PG8_WAIT_L(0); PG8_BAR; PG8_MMA(0, 0, At, B0); PG8_MMA(0, 1, At, B1); PG8_BAR; PG8_SCHED;
            PG8_LDA(At, 0, 1); PG8_STAGE(PG8_SB(0, 0), b2, voffB); PG8_STAGE(PG8_SB(0, 1), b2 + hstep, voffB); PG8_STAGE(PG8_SA(0, 0), a2, voffA);
            PG8_WAIT_V(8); PG8_WAIT_L(0); PG8_BAR; PG8_MMA(1, 0, At, B0); PG8_MMA(1, 1, At, B1); PG8_BAR; PG8_SCHED;
            PG8_LDB(B0, 1, 0); PG8_LDB(B1, 1, 1); PG8_SCHED; PG8_LDA(At, 1, 0); PG8_STAGE(PG8_SA(0, 1), a2 + hstep, voffA);
            PG8_WAIT_V(8); PG8_WAIT_L(0); PG8_BAR; PG8_MMA(0, 0, At, B0); PG8_MMA(0, 1, At, B1); PG8_BAR; PG8_SCHED;
            PG8_LDA(At, 1, 1); PG8_STAGE(PG8_SB(1, 0), b3, voffB); PG8_STAGE(PG8_SB(1, 1), b3 + hstep, voffB); PG8_STAGE(PG8_SA(1, 0), a3, voffA);
            PG8_WAIT_V(8); PG8_WAIT_L(0); PG8_BAR; PG8_MMA(1, 0, At, B0); PG8_MMA(1, 1, At, B1); PG8_BAR; PG8_SCHED;
            } else {
            PG8_LDB(B0, 0, 0); PG8_SCHED; PG8_LDA(At, 0, 0); PG8_STAGE(PG8_SA(1, 1), a1 + hstep, voffA);
            PG8_WAIT_L(8); PG8_BAR; PG8_WAIT_L(0); PG8_MMA(0, 0, At, B0); PG8_BAR; PG8_SCHED;
            PG8_LDB(B1, 0, 1); PG8_STAGE(PG8_SB(0, 0), b2, voffB);
            PG8_BAR; PG8_WAIT_L(0); PG8_MMA(0, 1, At, B1); PG8_BAR;
            PG8_LDA(At, 0, 1); PG8_STAGE(PG8_SA(0, 0), a2, voffA);
            PG8_BAR; PG8_WAIT_L(0); PG8_MMA(1, 0, At, B0); PG8_BAR; PG8_SCHED;
            PG8_STAGE(PG8_SB(0, 1), b2 + hstep, voffB);
            PG8_WAIT_V(6); PG8_BAR; PG8_MMA(1, 1, At, B1); PG8_BAR;
            PG8_LDB(B0, 1, 0); PG8_SCHED; PG8_LDA(At, 1, 0); PG8_STAGE(PG8_SA(0, 1), a2 + hstep, voffA);
            PG8_WAIT_L(8); PG8_BAR; PG8_WAIT_L(0); PG8_MMA(0, 0, At, B0); PG8_BAR; PG8_SCHED;
            PG8_LDB(B1, 1, 1); PG8_STAGE(PG8_SB(1, 0), b3, voffB);
            PG8_BAR; PG8_WAIT_L(0); PG8_MMA(0, 1, At, B1); PG8_BAR;
            PG8_LDA(At, 1, 1); PG8_STAGE(PG8_SA(1, 0), a3, voffA);
            PG8_BAR; PG8_WAIT_L(0); PG8_MMA(1, 0, At, B0); PG8_BAR; PG8_SCHED;
            PG8_STAGE(PG8_SB(1, 1), b3 + hstep, voffB);
            PG8_WAIT_V(6); PG8_BAR; PG8_MMA(1, 1, At, B1); PG8_BAR;
            }
        }
        if constexpr (ALIGN_EPI) { if (wr == 0) PG8_BAR; }
        if constexpr (!Epi::AFTER_DRAIN) { E(acc, cur, wr, wc, fr, fq); S.done(cur); }
        if (!has_next) break;
#pragma unroll
        for (int a = 0; a < 2; ++a)
#pragma unroll
            for (int b = 0; b < 2; ++b)
#pragma unroll
                for (int m = 0; m < 4; ++m)
#pragma unroll
                    for (int n = 0; n < 2; ++n) acc[a][b][m][n] = (f32x4){0.f, 0.f, 0.f, 0.f};
        cur = nxt; cA = nA; cB = nB; ++ui;
        if constexpr (ALIGN_EPI) { if (wr == 1) PG8_BAR; }
    }
    PG8_WAIT_V(0);
    if constexpr (!ALIGN_EPI) { if (wr == 0) PG8_BAR; }
    PG8_BAR;
    if constexpr (Epi::AFTER_DRAIN) { E.fused(acc, cur, wr, wc, fr, fq, lds, wid, lane); S.done(cur); }
#undef PG8_SA
#undef PG8_SB
#undef PG8_STAGE
#undef PG8_LDA
#undef PG8_LDB
#undef PG8_MMA
#undef PG8_WAIT_V
#undef PG8_WAIT_L
#undef PG8_BAR
#undef PG8_SCHED
}
}

#define DI __device__ __forceinline__
#define GAS __attribute__((address_space(1)))
#define LAS __attribute__((address_space(3)))
typedef unsigned short bf16;
typedef unsigned v4u __attribute__((ext_vector_type(4)));
typedef unsigned v2u __attribute__((ext_vector_type(2)));
typedef float f32x4 __attribute__((ext_vector_type(4)));
typedef float f32x2 __attribute__((ext_vector_type(2)));

constexpr int NWAVES = 8, NTHR = 512;
constexpr int DM = 2048, DIN = 8192, WA = 1024, NH = 8, HD = 128, DEPTH = 4;
constexpr int BATCH = 4, SEQ = 2048, NMETA = 16, DECB = 128, DECT = 4;
constexpr int ROW_S0 = BATCH * SEQ;
constexpr int ROW_M0 = ROW_S0 + DECB * DECT;
constexpr int M_ROWS = ROW_M0 + BATCH * NMETA;
constexpr int M_PAD = 8960;
constexpr float EPS = 1e-6f;
constexpr int TPB = NMETA + SEQ;

constexpr size_t O_YP = 0, O_YS = O_YP + (size_t)BATCH * SEQ * DM, O_SHP = O_YS + (size_t)DECB * DECT * DM,
                 O_SCP = O_SHP + (size_t)DEPTH * BATCH * NH * HD * HD, O_SHS = O_SCP + (size_t)DEPTH * BATCH * 2 * WA,
                 O_SCS = O_SHS + (size_t)DEPTH * DECB * NH * HD * HD, O_END = O_SCS + (size_t)DEPTH * DECB * 2 * WA;

constexpr size_t MiB = 1u << 20;
constexpr size_t WS_CTL = 0, CTL_ZERO_BYTES = 192 * 1024;
constexpr size_t WS_LB = 1 * MiB, WS_R2 = WS_LB + 64 * 1024, WS_CWT = WS_LB + 128 * 1024;
constexpr size_t WS_WIN = 2 * MiB;
constexpr size_t WS_WOUT = WS_WIN + 128 * MiB;
constexpr size_t WS_H = WS_WOUT + 32 * MiB;
constexpr size_t WS_HN = WS_H + 70 * MiB;
constexpr size_t HALF35 = 35 * MiB / 2;
constexpr size_t WS_Q = WS_HN + 35 * MiB;
constexpr size_t WS_K1 = WS_Q + HALF35, WS_V = WS_K1 + HALF35, WS_ZA = WS_V + HALF35, WS_U = WS_ZA + HALF35, WS_GT = WS_U + HALF35;
constexpr size_t WS_G = WS_GT + HALF35;
constexpr size_t WS_X = WS_G + 35 * MiB;
constexpr size_t WS_MIX = WS_X + 35 * MiB;
constexpr size_t WS_END = WS_MIX + 70 * MiB;
constexpr int XROWS = M_PAD - ROW_S0;
constexpr size_t WS_MIXP = 580 * MiB;
constexpr int CW_BAR = 4096;

constexpr int LDS_BYTES = 163840, MISC_OFF = LDS_BYTES - 128;

#define LDS_WAIT() asm volatile("s_waitcnt lgkmcnt(0)" ::: "memory")
#define VM_WAIT() asm volatile("s_waitcnt vmcnt(0)" ::: "memory")

DI float bf2f(unsigned short b) { return __uint_as_float(((unsigned)b) << 16); }
DI float bflo(unsigned w) { return __uint_as_float(w << 16); }
DI float bfhi(unsigned w) { return __uint_as_float(w & 0xffff0000u); }
DI unsigned pk2(float lo, float hi) { return pg8::cvt_pk_bf16(lo, hi); }
DI unsigned short f2bf1(float f) { return (unsigned short)(pk2(f, 0.f) & 0xffffu); }
DI void unpack8(const v4u w, float* d) { d[0] = bflo(w.x); d[1] = bfhi(w.x); d[2] = bflo(w.y); d[3] = bfhi(w.y); d[4] = bflo(w.z); d[5] = bfhi(w.z); d[6] = bflo(w.w); d[7] = bfhi(w.w); }
DI float row16_sum(float v) {
    v += __builtin_bit_cast(float, __builtin_amdgcn_update_dpp(0, __builtin_bit_cast(int, v), 0xB1, 0xF, 0xF, true));
    v += __builtin_bit_cast(float, __builtin_amdgcn_update_dpp(0, __builtin_bit_cast(int, v), 0x4E, 0xF, 0xF, true));
    v += __builtin_bit_cast(float, __builtin_amdgcn_update_dpp(0, __builtin_bit_cast(int, v), 0x141, 0xF, 0xF, true));
    v += __builtin_bit_cast(float, __builtin_amdgcn_update_dpp(0, __builtin_bit_cast(int, v), 0x140, 0xF, 0xF, true));
    return v;
}
DI float wave_sum(float v) {
    v = row16_sum(v);
    { const auto r = __builtin_amdgcn_permlane16_swap(__float_as_uint(v), __float_as_uint(v), false, false); v = __uint_as_float(r[0]) + __uint_as_float(r[1]); }
    { const auto r = __builtin_amdgcn_permlane32_swap(__float_as_uint(v), __float_as_uint(v), false, false); v = __uint_as_float(r[0]) + __uint_as_float(r[1]); }
    return v;
}
DI float fast_exp(float x) { return __expf(x); }
DI float sigmoidf(float x) { return __builtin_amdgcn_rcpf(1.0f + __expf(-x)); }
DI float siluf(float x) { return x * sigmoidf(x); }

#define XB_TMO      128
#define XB_XCNT(j)  (256  + 64 * (j))
#define XB_XSUB(j)  (1280 + 64 * (j))
#define XB_XGEN(j)  (2304 + 64 * (j))
#define XB_TOP      3328
#define XB_TOPGEN   3392
#define XCD_BAR_WORDS 3456
#define XB_SPIN_CAP (1u << 18)
DI unsigned xb_ld(unsigned* p)              { return __hip_atomic_load(p, __ATOMIC_RELAXED, __HIP_MEMORY_SCOPE_AGENT); }
DI unsigned xb_add(unsigned* p, unsigned v) { return __hip_atomic_fetch_add(p, v, __ATOMIC_RELAXED, __HIP_MEMORY_SCOPE_AGENT); }
DI unsigned xb_xcc_id() { return (unsigned)__builtin_amdgcn_s_getreg((3 << 11) | 20) & 0xFu; }
#define XB_SPIN(cond, bar) do { unsigned _sp = 0; while (cond) { __builtin_amdgcn_s_sleep(1); \
    if ((++_sp & 255u) == 0u) { if (xb_ld(&(bar)[XB_TMO])) break; if (_sp > XB_SPIN_CAP) { atomicAdd(&(bar)[XB_TMO], 1u); break; } } } } while (0)
struct XcdBarrier { unsigned* bar; unsigned x; volatile LAS unsigned* st; };
DI XcdBarrier xcd_barrier_post(unsigned* bar, volatile LAS unsigned* st) {
    XcdBarrier b; b.bar = bar; b.x = xb_xcc_id(); b.st = st;
    if (threadIdx.x == 0) (void)xb_add(&bar[XB_XCNT(b.x)], 1u);
    return b;
}
DI void xcd_barrier_complete(unsigned* bar, unsigned x, unsigned& nloc, unsigned& nx) {
    const unsigned G = gridDim.x * gridDim.y * gridDim.z;
    unsigned sum, cnt, mine, sp = 0u;
    for (;;) {
        sum = 0u; cnt = 0u; mine = 0u;
#pragma unroll
        for (unsigned j = 0; j < 16; ++j) { const unsigned c = xb_ld(&bar[XB_XCNT(j)]); sum += c; cnt += (c > 0u) ? 1u : 0u; mine = (j == x) ? c : mine; }
        if (sum == G) break;
        __builtin_amdgcn_s_sleep(1);
        if ((++sp & 255u) == 0u) { if (xb_ld(&bar[XB_TMO])) break; if (sp > XB_SPIN_CAP) { atomicAdd(&bar[XB_TMO], 1u); break; } }
    }
    nloc = mine > 0u ? mine : 1u; nx = cnt > 0u ? cnt : 1u;
}
DI void xcd_barrier(const XcdBarrier& b) {
    asm volatile("s_waitcnt vmcnt(0)" ::: "memory");
    __syncthreads();
    if (threadIdx.x == 0) {
        unsigned* bar = b.bar;
        __builtin_amdgcn_s_waitcnt(0);
        unsigned nloc = b.st[0], nx = b.st[1];
        if (nloc == 0u) { xcd_barrier_complete(bar, b.x, nloc, nx); b.st[0] = nloc; b.st[1] = nx; }
        const unsigned old = xb_add(&bar[XB_XSUB(b.x)], 1u);
        const unsigned gen = old / nloc;
        if (old + 1u == (gen + 1u) * nloc) {
            __builtin_amdgcn_fence(__ATOMIC_RELEASE, "agent");
            asm volatile("s_waitcnt vmcnt(0)" ::: "memory");
            const unsigned og = xb_add(&bar[XB_TOP], 1u);
            const unsigned tg = og / nx;
            if (og + 1u == (tg + 1u) * nx) xb_add(&bar[XB_TOPGEN], 1u);
            else XB_SPIN(xb_ld(&bar[XB_TOPGEN]) == tg, bar);
            __builtin_amdgcn_fence(__ATOMIC_ACQUIRE, "agent");
            xb_add(&bar[XB_XGEN(b.x)], 1u);
            asm volatile("s_waitcnt vmcnt(0)" ::: "memory");
        } else {
            XB_SPIN(xb_ld(&bar[XB_XGEN(b.x)]) == gen, bar);
            __builtin_amdgcn_fence(__ATOMIC_ACQUIRE, "agent");
            asm volatile("s_waitcnt vmcnt(0)" ::: "memory");
        }
    }
    __syncthreads();
}

struct Ctx {
    LAS unsigned char* lds;
    int vcu, G;
    const float *x_prompt, *x_sample, *state_hgrn, *state_conv, *meta, *w_in, *conv_w, *lb_param, *hgrn_nw, *w_out, *pre_w, *post_w;
    float* out;
    unsigned char* ws;
};
struct Tid { int tid, lane, wave; };
DI Tid get_tid() {
    int t = threadIdx.x; asm volatile("" : "+v"(t));
    Tid r; r.tid = t; r.lane = t & 63; r.wave = __builtin_amdgcn_readfirstlane(t >> 6); return r;
}
DI const float* in_row(const Ctx& c, int row) {
    if (row < ROW_S0) return c.x_prompt + (size_t)row * DM;
    if (row < ROW_M0) return c.x_sample + (size_t)(row - ROW_S0) * DM;
    return c.meta + (size_t)((row - ROW_M0) & (NMETA - 1)) * DM;
}
DI int prompt_row(int b, int p) { return p < NMETA ? ROW_M0 + b * NMETA + p : b * SEQ + (p - NMETA); }

DI int src_col_in(int np) {
    if (np < 4096) return np;
    const int pn = np >> 8, p = np & 255;
    const int s = 2 * (p >> 7) + ((p >> 2) & 1), wc = (p >> 5) & 3, fq = (p >> 3) & 3, j = p & 3;
    return 4096 + s * 1024 + (pn - 16) * 64 + 16 * wc + 4 * fq + j;
}

DI void transpose_item(const float* W, int K, int N, bf16* WT, LAS float* scr, int item, int lane, bool perm, const float* kscale) {
    const int nblk = N / 64, kb = item / nblk, nb = item - kb * nblk, k0 = 64 * kb, n0 = 64 * nb;
    const int np4 = n0 + 4 * (lane & 15);
    const int sc = perm ? src_col_in(np4) : np4;
    f32x4 v[16];
#pragma unroll
    for (int i = 0; i < 16; ++i) v[i] = __builtin_nontemporal_load((const f32x4*)(W + (size_t)(k0 + 4 * i + (lane >> 4)) * N + sc));
#pragma unroll
    for (int i = 0; i < 16; ++i) { const int kk = 4 * i + (lane >> 4); const float ks = kscale ? kscale[k0 + kk] : 1.0f; LAS float* d = scr + kk * 65 + 4 * (lane & 15);
        d[0] = v[i].x * ks; d[1] = v[i].y * ks; d[2] = v[i].z * ks; d[3] = v[i].w * ks; }
    LDS_WAIT();
    const int c8 = lane & 7;
#pragma unroll
    for (int j = 0; j < 8; ++j) { const int n = (lane >> 3) + 8 * j; const LAS float* s = scr + (8 * c8) * 65 + n;
        v4u o; o.x = pk2(s[0 * 65], s[1 * 65]); o.y = pk2(s[2 * 65], s[3 * 65]); o.z = pk2(s[4 * 65], s[5 * 65]); o.w = pk2(s[6 * 65], s[7 * 65]);
        *(v4u*)(WT + (size_t)(n0 + n) * K + k0 + 8 * c8) = o; }
    LDS_WAIT();
}
constexpr int PREP_I_IN = (DM / 64) * (DIN / 64), PREP_I_OUT = (DM / 64) * (DM / 64), PREP_ITEMS = PREP_I_IN + PREP_I_OUT;
DI void prep_layer(const Ctx& c, int l, int it_lo, int it_hi, int it_step) {
    const Tid t_ = get_tid(); const int lane = t_.lane, wave = t_.wave;
    LAS float* scr = (LAS float*)(c.lds + wave * 16640);
    for (int it = it_lo + wave; it < it_hi; it += it_step) {
        if (it < PREP_I_IN) transpose_item(c.w_in + (size_t)l * DM * DIN, DM, DIN, (bf16*)(c.ws + WS_WIN) + (size_t)l * DIN * DM, scr, it, lane, true, c.pre_w + (size_t)l * DM);
        else transpose_item(c.w_out + (size_t)l * DM * DM, DM, DM, (bf16*)(c.ws + WS_WOUT) + (size_t)l * DM * DM, scr, it - PREP_I_IN, lane, false, nullptr);
    }
}
DI void phase_prep(const Ctx& c) {
    const Tid t_ = get_tid(); const int tid = t_.tid;
    prep_layer(c, 0, c.vcu * NWAVES, PREP_I_IN, c.G * NWAVES);
    for (int i = c.vcu * NTHR + tid; i < DEPTH * 3 * WA; i += c.G * NTHR) ((float*)(c.ws + WS_CWT))[i] = c.conv_w[i];
    const int gt = c.vcu * NTHR + tid;
    if (gt < WA) {
        float p[DEPTH], mx = -3.0e38f;
#pragma unroll
        for (int l = 0; l < DEPTH; ++l) { p[l] = c.lb_param[l * WA + gt]; mx = fmaxf(mx, p[l]); }
        float s = 0.f;
#pragma unroll
        for (int l = 0; l < DEPTH; ++l) { p[l] = expf(p[l] - mx); s += p[l]; }
        float* LB = (float*)(c.ws + WS_LB); float cum = 0.f;
#pragma unroll
        for (int l = 0; l < DEPTH; ++l) { if (l > 0) cum += p[l] / s; LB[l * WA + gt] = cum; }
    }
}

struct NormRow { f32x4 hf[8]; v4u hb[4]; v4u mx[4]; };
DI void norm_row_load(const Ctx& c, int l, int row, int lane, NormRow& R) {
    const bf16* Hb = (const bf16*)(c.ws + WS_HN); const bf16* MIX = (const bf16*)(c.ws + WS_MIX);
    if (l == 0) { const float* src = in_row(c, row);
#pragma unroll
        for (int j = 0; j < 4; ++j) { R.hf[2 * j] = *(const f32x4*)(src + 8 * (lane + 64 * j)); R.hf[2 * j + 1] = *(const f32x4*)(src + 8 * (lane + 64 * j) + 4); } }
    else {
#pragma unroll
        for (int j = 0; j < 4; ++j) R.hb[j] = __builtin_nontemporal_load((const v4u*)(Hb + (size_t)row * DM + 8 * (lane + 64 * j))); }
    if (l >= 1 && row < ROW_S0) {
#pragma unroll
        for (int j = 0; j < 4; ++j) R.mx[j] = __builtin_nontemporal_load((const v4u*)(MIX + (size_t)row * DM + 8 * (lane + 64 * j))); }
}
DI void norm_row_finish(const Ctx& c, int l, int row, int lane, const NormRow& R, bool dry) {
    bf16* Hb = (bf16*)(c.ws + WS_HN); float* R2 = (float*)(c.ws + WS_R2);
    float h[32];
    if (l == 0) {
#pragma unroll
        for (int j = 0; j < 8; ++j) { h[4 * j] = R.hf[j].x; h[4 * j + 1] = R.hf[j].y; h[4 * j + 2] = R.hf[j].z; h[4 * j + 3] = R.hf[j].w; } }
    else {
#pragma unroll
        for (int j = 0; j < 4; ++j) unpack8(R.hb[j], h + 8 * j); }
    if (l >= 1) {
        float m[32]; float ss = 0.f;
        if (row < ROW_S0) {
#pragma unroll
            for (int j = 0; j < 4; ++j) unpack8(R.mx[j], m + 8 * j); }
        else {
            const bf16* MP = (const bf16*)(c.ws + WS_MIXP) + (size_t)(row - ROW_S0) * DM;
#pragma unroll
            for (int e = 0; e < 32; ++e) m[e] = 0.f;
#pragma unroll
            for (int q = 0; q < 4; ++q)
#pragma unroll
                for (int j = 0; j < 4; ++j) { float t8[8]; unpack8(*(const v4u*)(MP + (size_t)q * XROWS * DM + 8 * (lane + 64 * j)), t8);
#pragma unroll
                    for (int e = 0; e < 8; ++e) m[8 * j + e] += t8[e]; } }
#pragma unroll
        for (int e = 0; e < 32; ++e) ss += m[e] * m[e];
        const float r1 = __builtin_amdgcn_rsqf(wave_sum(ss) * (1.0f / DM) + EPS);
        const float* wp = c.post_w + (size_t)(l - 1) * DM;
#pragma unroll
        for (int j = 0; j < 4; ++j) { const f32x4 a = *(const f32x4*)(wp + 8 * (lane + 64 * j)), b2 = *(const f32x4*)(wp + 8 * (lane + 64 * j) + 4);
            h[8 * j] += m[8 * j] * r1 * a.x; h[8 * j + 1] += m[8 * j + 1] * r1 * a.y; h[8 * j + 2] += m[8 * j + 2] * r1 * a.z; h[8 * j + 3] += m[8 * j + 3] * r1 * a.w;
            h[8 * j + 4] += m[8 * j + 4] * r1 * b2.x; h[8 * j + 5] += m[8 * j + 5] * r1 * b2.y; h[8 * j + 6] += m[8 * j + 6] * r1 * b2.z; h[8 * j + 7] += m[8 * j + 7] * r1 * b2.w; }
    }
    if (l < DEPTH) {
        float ss = 0.f;
#pragma unroll
        for (int e = 0; e < 32; ++e) ss += h[e] * h[e];
        const float r2 = __builtin_amdgcn_rsqf(wave_sum(ss) * (1.0f / DM) + EPS);
        if (!dry) {
#pragma unroll
            for (int j = 0; j < 4; ++j) { v4u o; o.x = pk2(h[8 * j], h[8 * j + 1]); o.y = pk2(h[8 * j + 2], h[8 * j + 3]); o.z = pk2(h[8 * j + 4], h[8 * j + 5]); o.w = pk2(h[8 * j + 6], h[8 * j + 7]);
                *(v4u*)(Hb + (size_t)row * DM + 8 * (lane + 64 * j)) = o; }
            if (lane == 0) R2[row] = r2; }
    } else {
        float* dst = row < ROW_S0 ? c.out + O_YP + (size_t)row * DM : (row < ROW_M0 ? c.out + O_YS + (size_t)(row - ROW_S0) * DM : nullptr);
        if (dst) {
#pragma unroll
            for (int j = 0; j < 4; ++j) { __builtin_nontemporal_store((f32x4){h[8 * j], h[8 * j + 1], h[8 * j + 2], h[8 * j + 3]}, (f32x4*)(dst + 8 * (lane + 64 * j)));
                __builtin_nontemporal_store((f32x4){h[8 * j + 4], h[8 * j + 5], h[8 * j + 6], h[8 * j + 7]}, (f32x4*)(dst + 8 * (lane + 64 * j) + 4)); } }
    }
}
DI void norm_rows(const Ctx& c, int l, int row_lo, int row_hi, int row_step, bool dry = false) {
    const Tid t_ = get_tid(); const int lane = t_.lane, wave = t_.wave;
    if (l == 0) {
        for (int row = row_lo + wave; row < row_hi; row += row_step) { NormRow A; norm_row_load(c, l, row, lane, A); norm_row_finish(c, l, row, lane, A, dry); }
        return; }
    for (int row = row_lo + wave; row < row_hi; row += 2 * row_step) {
        const int rowb = row + row_step;
        NormRow A, B;
        norm_row_load(c, l, row, lane, A);
        if (rowb < row_hi) norm_row_load(c, l, rowb, lane, B);
        norm_row_finish(c, l, row, lane, A, dry);
        if (rowb < row_hi) norm_row_finish(c, l, rowb, lane, B, dry);
    }
}
DI void phase_norm(const Ctx& c, int l) { norm_rows(c, l, c.vcu * NWAVES, M_ROWS, c.G * NWAVES); }

namespace pg8 {
struct EpiInProj {
    static constexpr bool PERM = true, AFTER_DRAIN = false;
    unsigned char* ws; int l, pad_;
    __device__ __forceinline__ void operator()(const f32x4 (&acc_in)[2][2][4][2], const Unit& u, int wr, int wc, int fr, int fq) const {
        const int row0 = u.pm * BM + wr * 64 + fr, pn = u.pn;
        f32x4 acc[2][2][4][2];
        { const float* R2 = (const float*)(ws + WS_R2);
#pragma unroll
          for (int ai = 0; ai < 2; ++ai)
#pragma unroll
              for (int m = 0; m < 4; ++m) { const float r2 = R2[row0 + ai * HALF + m * 16];
#pragma unroll
                  for (int bj = 0; bj < 2; ++bj)
#pragma unroll
                      for (int n = 0; n < 2; ++n) acc[ai][bj][m][n] = acc_in[ai][bj][m][n] * r2; } }
        float* const G = (float*)(ws + WS_G); bf16_t* const K1 = (bf16_t*)(ws + WS_K1); bf16_t* const U = (bf16_t*)(ws + WS_U); bf16_t* const GT = (bf16_t*)(ws + WS_GT);
        const float* const lb = (const float*)(ws + WS_LB) + l * 1024;
        if (pn < 16) {
            const int seg = pn >> 2, col0 = (pn & 3) * 256 + wc * 32 + 8 * fq;
            if (seg == 1) {
                f32x4 lbv[2][2];
#pragma unroll
                for (int bj = 0; bj < 2; ++bj)
#pragma unroll
                    for (int n = 0; n < 2; ++n) lbv[bj][n] = *(const f32x4*)(lb + col0 + bj * HALF + 4 * n);
#pragma unroll
                for (int ai = 0; ai < 2; ++ai)
#pragma unroll
                    for (int m = 0; m < 4; ++m) { const size_t ro = (size_t)(row0 + ai * HALF + m * 16) * 1024 + col0;
#pragma unroll
                        for (int bj = 0; bj < 2; ++bj) { f32x4 gk[2], kk[2];
#pragma unroll
                            for (int n = 0; n < 2; ++n)
#pragma unroll
                                for (int e = 0; e < 4; ++e) { const float z = acc[ai][bj][m][n][e], lbe = lbv[bj][n][e];
                                    const float ez = __expf(-fabsf(z)), sp = __builtin_amdgcn_rcpf(1.0f + ez), sn = ez * sp;
                                    const float sg = z >= 0.f ? sp : sn, sm = z >= 0.f ? sn : sp;
                                    const float f = lbe + (1.0f - lbe) * sg;
                                    gk[n][e] = __logf(fmaxf(f, 1e-30f)); kk[n][e] = (1.0f - lbe) * sm; }
                            *(f32x4*)(G + ro + bj * HALF) = gk[0]; *(f32x4*)(G + ro + bj * HALF + 4) = gk[1];
                            u32x4 w; w.x = cvt_pk_bf16(kk[0][0], kk[0][1]); w.y = cvt_pk_bf16(kk[0][2], kk[0][3]); w.z = cvt_pk_bf16(kk[1][0], kk[1][1]); w.w = cvt_pk_bf16(kk[1][2], kk[1][3]);
                            *(u32x4*)(K1 + ro + bj * HALF) = w; } }
            } else {
                bf16_t* base = (bf16_t*)(ws + (seg == 0 ? WS_Q : (seg == 2 ? WS_V : WS_ZA)));
#pragma unroll
                for (int ai = 0; ai < 2; ++ai)
#pragma unroll
                    for (int m = 0; m < 4; ++m) { const size_t ro = (size_t)(row0 + ai * HALF + m * 16) * 1024 + col0;
#pragma unroll
                        for (int bj = 0; bj < 2; ++bj) { f32x4 v0 = acc[ai][bj][m][0], v1 = acc[ai][bj][m][1];
                            if (seg == 3) {
#pragma unroll
                                for (int e = 0; e < 4; ++e) { v0[e] = v0[e] * __builtin_amdgcn_rcpf(1.0f + __expf(-v0[e])); v1[e] = v1[e] * __builtin_amdgcn_rcpf(1.0f + __expf(-v1[e])); } }
                            u32x4 w; w.x = cvt_pk_bf16(v0[0], v0[1]); w.y = cvt_pk_bf16(v0[2], v0[3]); w.z = cvt_pk_bf16(v1[0], v1[1]); w.w = cvt_pk_bf16(v1[2], v1[3]);
                            *(u32x4*)(base + ro + bj * HALF) = w; } }
            }
        } else {
            const int ch0 = (pn - 16) * 64 + wc * 16 + fq * 4;
            typedef unsigned u32x2 __attribute__((ext_vector_type(2)));
            if (u.pm < ROW_S0 / BM) {
                const float* cwt = (const float*)(ws + WS_CWT) + (size_t)l * 3 * 1024 + ch0;
                const f32x4 w0 = *(const f32x4*)cwt, w1 = *(const f32x4*)(cwt + 1024), w2 = *(const f32x4*)(cwt + 2048);
                bf16_t* const X = (bf16_t*)(ws + WS_X);
#pragma unroll
                for (int ai = 0; ai < 2; ++ai) { f32x4 p1 = {0.f, 0.f, 0.f, 0.f}, p2 = p1;
#pragma unroll
                    for (int m = 0; m < 4; ++m) { const size_t row = (size_t)(row0 + ai * HALF + m * 16), ro = row * 1024 + ch0;
                        const f32x4 bg = acc[ai][0][m][0], cg = acc[ai][0][m][1], xt = acc[ai][1][m][0], zb = acc[ai][1][m][1];
                        f32x4 uu = cg * xt, gt, t1, t2;
#pragma unroll
                        for (int e = 0; e < 4; ++e) { gt[e] = bg[e] * zb[e] * __builtin_amdgcn_rcpf(1.0f + __expf(-zb[e]));
                            float r1_, r2_; const float ue_ = uu[e];
                            asm volatile("s_nop 1\n\tv_mov_b32_dpp %0, %2 row_ror:1 row_mask:0xf bank_mask:0xf bound_ctrl:1\n\tv_mov_b32_dpp %1, %2 row_ror:2 row_mask:0xf bank_mask:0xf bound_ctrl:1" : "=&v"(r1_), "=&v"(r2_) : "v"(ue_));
                            t1[e] = r1_; t2[e] = r2_; }
                        const f32x4 q1 = fr >= 1 ? t1 : p1, q2 = fr >= 2 ? t2 : p2;
                        const f32x4 y = gt * (w0 * q2 + w1 * q1 + w2 * uu);
                        u32x2 yo; yo.x = cvt_pk_bf16(y[0], y[1]); yo.y = cvt_pk_bf16(y[2], y[3]);
                        *(u32x2*)(X + row * 2048 + 1024 + ch0) = yo;
                        if ((m == 0 && fr < 2) || (m == 3 && fr >= 14)) { u32x2 a; a.x = cvt_pk_bf16(uu[0], uu[1]); a.y = cvt_pk_bf16(uu[2], uu[3]); *(u32x2*)(U + ro) = a; }
                        if (m == 0 && fr < 2) { u32x2 b; b.x = cvt_pk_bf16(gt[0], gt[1]); b.y = cvt_pk_bf16(gt[2], gt[3]); *(u32x2*)(GT + ro) = b; }
                        p1 = t1; p2 = t2; } }
            } else
#pragma unroll
            for (int ai = 0; ai < 2; ++ai)
#pragma unroll
                for (int m = 0; m < 4; ++m) { const size_t ro = (size_t)(row0 + ai * HALF + m * 16) * 1024 + ch0;
                    const f32x4 bg = acc[ai][0][m][0], cg = acc[ai][0][m][1], xt = acc[ai][1][m][0], zb = acc[ai][1][m][1];
                    f32x4 uu = cg * xt, gt;
#pragma unroll
                    for (int e = 0; e < 4; ++e) gt[e] = bg[e] * zb[e] * __builtin_amdgcn_rcpf(1.0f + __expf(-zb[e]));
                    u32x2 a, b; a.x = cvt_pk_bf16(uu[0], uu[1]); a.y = cvt_pk_bf16(uu[2], uu[3]); b.x = cvt_pk_bf16(gt[0], gt[1]); b.y = cvt_pk_bf16(gt[2], gt[3]);
                    *(u32x2*)(U + ro) = a; *(u32x2*)(GT + ro) = b; }
        }
    }
};
struct EpiMix {
    static constexpr bool PERM = true, AFTER_DRAIN = false;
    bf16_t* C;
    __device__ __forceinline__ void operator()(const f32x4 (&acc)[2][2][4][2], const Unit& u, int wr, int wc, int fr, int fq) const {
        const int row0 = u.pm * BM + wr * 64 + fr, col0 = u.pn * BM + wc * 32 + 8 * fq;
        const __amdgpu_buffer_rsrc_t rs = __builtin_amdgcn_make_buffer_rsrc((void*)C, (short)0, (int)(35u << 20), 0x00020000);
#pragma unroll
        for (int ai = 0; ai < 2; ++ai)
#pragma unroll
            for (int m = 0; m < 4; ++m) { const unsigned ro = (unsigned)(((row0 + ai * HALF + m * 16) * 2048 + col0) * 2);
#pragma unroll
                for (int bj = 0; bj < 2; ++bj) { const f32x4 v0 = acc[ai][bj][m][0], v1 = acc[ai][bj][m][1];
                    u32x4 w; w.x = cvt_pk_bf16(v0[0], v0[1]); w.y = cvt_pk_bf16(v0[2], v0[3]); w.z = cvt_pk_bf16(v1[0], v1[1]); w.w = cvt_pk_bf16(v1[2], v1[3]);
                    __builtin_amdgcn_raw_buffer_store_b128(w, rs, (int)(ro + bj * HALF * 2), 0, 16); } }
    }
};
}

DI void phase_conv(const Ctx& c, int l, int wi, int nw_) {
    const bf16* U = (const bf16*)(c.ws + WS_U); const bf16* GT = (const bf16*)(c.ws + WS_GT); bf16* X = (bf16*)(c.ws + WS_X);
    const Tid t_ = get_tid(); const int tid = t_.tid;
    const int sub = tid >> 7, ch0 = (tid & 127) * 8;
    const float* cw = c.conv_w + (size_t)l * 3 * WA + ch0;
    float w0[8], w1[8], w2[8];
#pragma unroll
    for (int e = 0; e < 8; ++e) { w0[e] = cw[e]; w1[e] = cw[WA + e]; w2[e] = cw[2 * WA + e]; }
    const bool blk32 = nw_ == 0;
    const int row_lo = blk32 ? wi * 32 + sub : wi * 4 + sub, row_hi = blk32 ? (wi * 32 + 32 < M_ROWS ? wi * 32 + 32 : M_ROWS) : M_ROWS, row_st = blk32 ? 4 : nw_ * 4;
    const int n_it = nw_ == -1 ? 4 : (row_hi - row_lo + row_st - 1) / row_st;
    for (int it = 0; it < n_it; ++it) {
        const int row = nw_ == -1 ? 64 * (wi * 8 + it * 2 + (sub >> 1)) + (sub & 1) : row_lo + it * row_st;
        int r1, r2, db = 0;
        if (row < ROW_S0) { const int b = row >> 11, t = row & (SEQ - 1);
            r1 = t >= 1 ? row - 1 : ROW_M0 + b * NMETA + 15;
            r2 = t >= 2 ? row - 2 : ROW_M0 + b * NMETA + 14 + t; }
        else if (row < ROW_M0) { const int idx = row - ROW_S0, j = idx & 3; db = idx >> 2;
            r1 = j >= 1 ? row - 1 : -2;
            r2 = j >= 2 ? row - 2 : (j == 1 ? -2 : -3); }
        else { const int m = (row - ROW_M0) & 15;
            r1 = m >= 1 ? row - 1 : -1;
            r2 = m >= 2 ? row - 2 : -1; }
        float u0[8], u1[8], u2[8];
        { const v4u w = *(const v4u*)(U + (size_t)row * WA + ch0);
          u0[0] = bflo(w.x); u0[1] = bfhi(w.x); u0[2] = bflo(w.y); u0[3] = bfhi(w.y); u0[4] = bflo(w.z); u0[5] = bfhi(w.z); u0[6] = bflo(w.w); u0[7] = bfhi(w.w); }
#pragma unroll
        for (int which = 0; which < 2; ++which) {
            const int r = which == 0 ? r1 : r2; float* d = which == 0 ? u1 : u2;
            if (r >= 0) { const v4u w = *(const v4u*)(U + (size_t)r * WA + ch0);
                d[0] = bflo(w.x); d[1] = bfhi(w.x); d[2] = bflo(w.y); d[3] = bfhi(w.y); d[4] = bflo(w.z); d[5] = bfhi(w.z); d[6] = bflo(w.w); d[7] = bfhi(w.w); }
            else if (r == -1) {
#pragma unroll
                for (int e = 0; e < 8; ++e) d[e] = 0.f; }
            else { const float* sc = c.state_conv + (((size_t)l * DECB + db) * 2 + (r == -2 ? 1 : 0)) * WA + ch0;
#pragma unroll
                for (int e = 0; e < 8; ++e) d[e] = sc[e]; }
        }
        const v4u gw = *(const v4u*)(GT + (size_t)row * WA + ch0);
        float g[8] = {bflo(gw.x), bfhi(gw.x), bflo(gw.y), bfhi(gw.y), bflo(gw.z), bfhi(gw.z), bflo(gw.w), bfhi(gw.w)};
        float y[8];
#pragma unroll
        for (int e = 0; e < 8; ++e) y[e] = g[e] * (w0[e] * u2[e] + w1[e] * u1[e] + w2[e] * u0[e]);
        v4u o; o.x = pk2(y[0], y[1]); o.y = pk2(y[2], y[3]); o.z = pk2(y[4], y[5]); o.w = pk2(y[6], y[7]);
        *(v4u*)(X + (size_t)row * DM + WA + ch0) = o;
        float* so = nullptr;
        if (row < ROW_S0) { const int b = row >> 11, t = row & (SEQ - 1); if (t >= SEQ - 2) so = c.out + O_SCP + (((size_t)l * BATCH + b) * 2 + (t - (SEQ - 2))) * WA + ch0; }
        else if (row < ROW_M0) { const int idx = row - ROW_S0, j = idx & 3; if (j >= 2) so = c.out + O_SCS + (((size_t)l * DECB + (idx >> 2)) * 2 + (j - 2)) * WA + ch0; }
        if (so) { *(f32x4*)so = (f32x4){u0[0], u0[1], u0[2], u0[3]}; *(f32x4*)(so + 4) = (f32x4){u0[4], u0[5], u0[6], u0[7]}; }
    }
    if (nw_ == -1 && wi == 0) {
#pragma unroll
        for (int i = 0; i < 2; ++i) { const int q = sub + 4 * i, b = q >> 1, j = q & 1, row = b * SEQ + SEQ - 2 + j;
            float u0[8]; unpack8(*(const v4u*)(U + (size_t)row * WA + ch0), u0);
            float* so = c.out + O_SCP + (((size_t)l * BATCH + b) * 2 + j) * WA + ch0;
            *(f32x4*)so = (f32x4){u0[0], u0[1], u0[2], u0[3]}; *(f32x4*)(so + 4) = (f32x4){u0[4], u0[5], u0[6], u0[7]}; } }
}

DI void hgrn_sample_item(const Ctx& c, int l, int item) {
    const int db = item >> 3, h = item & 7, hc = h * HD; const Tid t_ = get_tid(); const int tid = t_.tid, lane = t_.lane, wave = t_.wave;
    LAS float* sQ = (LAS float*)c.lds;
    LAS float* sG = sQ + 512; LAS float* sK = sG + 512; LAS float* sV = sK + 512; LAS float* sZ = sV + 512;
    LAS float* sQE = sZ + 512; LAS float* sKH = sQE + 512; LAS float* sD = sKH + 512;
    LAS float* sA = sD + 128;
    LAS float* sSS = sA + 16;
    LAS float* sRed = sSS + 16;
    const bf16* Q = (const bf16*)(c.ws + WS_Q); const bf16* K1 = (const bf16*)(c.ws + WS_K1); const bf16* V = (const bf16*)(c.ws + WS_V); const bf16* ZA = (const bf16*)(c.ws + WS_ZA);
    const float* G = (const float*)(c.ws + WS_G); bf16* X = (bf16*)(c.ws + WS_X);
    const int row0 = ROW_S0 + db * DECT;
    { const int j = tid >> 7, cc = tid & 127; const size_t o = (size_t)(row0 + j) * WA + hc + cc;
      sQ[tid] = bf2f(Q[o]); sG[tid] = G[o]; sK[tid] = bf2f(K1[o]); sV[tid] = bf2f(V[o]); sZ[tid] = bf2f(ZA[o]); }
    const int kr = tid >> 5, v4 = tid & 31;
    const float* S0 = c.state_hgrn + (((size_t)l * DECB + db) * NH + h) * (size_t)(HD * HD);
    float* S1 = c.out + O_SHS + (((size_t)l * DECB + db) * NH + h) * (size_t)(HD * HD);
    f32x4 s[8];
#pragma unroll
    for (int i = 0; i < 8; ++i) s[i] = __builtin_nontemporal_load((const f32x4*)(S0 + (size_t)(kr + 16 * i) * HD + 4 * v4));
    __syncthreads();
    if (tid < 128) {
        const float g0 = sG[tid], g1 = g0 + sG[128 + tid], g2 = g1 + sG[256 + tid], g3 = g2 + sG[384 + tid];
        sG[tid] = g0; sG[128 + tid] = g1; sG[256 + tid] = g2; sG[384 + tid] = g3;
        sQE[tid] = sQ[tid] * __expf(g0); sQE[128 + tid] = sQ[128 + tid] * __expf(g1); sQE[256 + tid] = sQ[256 + tid] * __expf(g2); sQE[384 + tid] = sQ[384 + tid] * __expf(g3);
        sKH[tid] = sK[tid] * __expf(g3 - g0); sKH[128 + tid] = sK[128 + tid] * __expf(g3 - g1); sKH[256 + tid] = sK[256 + tid] * __expf(g3 - g2); sKH[384 + tid] = sK[384 + tid];
        sD[tid] = __expf(g3);
    }
    __syncthreads();
    for (int p = wave; p < 10; p += NWAVES) {
        int t = 0, s2 = p; if (p >= 6) { t = 3; s2 = p - 6; } else if (p >= 3) { t = 2; s2 = p - 3; } else if (p >= 1) { t = 1; s2 = p - 1; }
        float a = 0.f;
#pragma unroll
        for (int q = 0; q < 2; ++q) { const int k = lane + 64 * q; a += sQ[t * 128 + k] * sK[s2 * 128 + k] * __expf(sG[t * 128 + k] - sG[s2 * 128 + k]); }
        a = wave_sum(a);
        if (lane == 0) sA[t * 4 + s2] = a;
    }
    f32x4 op[4];
#pragma unroll
    for (int t = 0; t < 4; ++t) op[t] = (f32x4){0.f, 0.f, 0.f, 0.f};
    f32x4 vv[4];
#pragma unroll
    for (int t = 0; t < 4; ++t) vv[t] = *(const LAS f32x4*)(sV + t * 128 + 4 * v4);
#pragma unroll
    for (int i = 0; i < 8; ++i) { const int k = kr + 16 * i;
        const f32x4 s0 = s[i];
#pragma unroll
        for (int t = 0; t < 4; ++t) op[t] = op[t] + s0 * sQE[t * 128 + k];
        f32x4 sn = s0 * sD[k];
#pragma unroll
        for (int t = 0; t < 4; ++t) sn = sn + vv[t] * sKH[t * 128 + k];
        __builtin_nontemporal_store(sn, (f32x4*)(S1 + (size_t)k * HD + 4 * v4)); }
#pragma unroll
    for (int t = 0; t < 4; ++t) {
#pragma unroll
        for (int e = 0; e < 4; ++e) op[t][e] += __shfl_xor(op[t][e], 32);
        if (lane < 32) *(LAS f32x4*)(sRed + (wave * 4 + t) * 128 + 4 * v4) = op[t]; }
    __syncthreads();
    { const int t = tid >> 7, v = tid & 127; float o = 0.f;
#pragma unroll
      for (int w = 0; w < NWAVES; ++w) o += sRed[(w * 4 + t) * 128 + v];
      for (int s2 = 0; s2 <= t; ++s2) o += sA[t * 4 + s2] * sV[s2 * 128 + v];
      const float ss = wave_sum(o * o);
      if (lane == 0) sSS[wave] = ss;
      __syncthreads();
      const float tot = sSS[2 * t] + sSS[2 * t + 1];
      const float r = 1.0f / sqrtf(tot * (1.0f / HD) + EPS);
      X[(size_t)(row0 + t) * DM + hc + v] = f2bf1(o * r * c.hgrn_nw[l * HD + v] * sZ[t * 128 + v]); }
    __syncthreads();
}


typedef short bf16x8 __attribute__((ext_vector_type(8)));
typedef float f32x16 __attribute__((ext_vector_type(16)));
typedef float f32x2_t __attribute__((ext_vector_type(2))); typedef __bf16 bf16x2_t __attribute__((ext_vector_type(2)));
DI unsigned cvtpk(float lo, float hi) { f32x2_t v = {lo, hi}; bf16x2_t b = __builtin_convertvector(v, bf16x2_t); return __builtin_bit_cast(unsigned, b); }
DI int crow(int reg, int h) { return (reg & 3) + 8 * (reg >> 2) + 4 * h; }
constexpr int NCH = 33, NCI = BATCH * NH * NCH;
constexpr size_t WS_QT = 512 * MiB, WS_KHT = 529 * MiB, WS_VT = 546 * MiB, WS_AM = 563 * MiB, WS_DG = 572 * MiB, WS_ENDQ = 573 * MiB, WS_END2 = 600 * MiB;
static_assert(WS_MIXP >= WS_ENDQ && WS_MIXP + 4 * (size_t)XROWS * DM * 2 <= WS_END2, "partials map");
static_assert(WS_END <= WS_QT && (size_t)NCI * 64 * 128 * 2 <= 17 * MiB && (size_t)NCI * 64 * 64 * 2 <= 9 * MiB && (size_t)NCI * 128 * 4 <= MiB, "chunk operand map");
constexpr int CW_FLAG = 16384, FLAG_STRIDE = 16;
#define RLX_AGENT __ATOMIC_RELAXED, __HIP_MEMORY_SCOPE_AGENT
DI __amdgpu_buffer_rsrc_t mk_rsrc(unsigned char* p, unsigned bytes) { return __builtin_amdgcn_make_buffer_rsrc((void*)p, (short)0, (int)bytes, 0x00020000); }
constexpr unsigned RS_ALL = (unsigned)(WS_ENDQ - WS_QT), RO_KH = (unsigned)(WS_KHT - WS_QT), RO_VT = (unsigned)(WS_VT - WS_QT), RO_AM = (unsigned)(WS_AM - WS_QT), RO_DG = (unsigned)(WS_DG - WS_QT);
DI void st_sc1(__amdgpu_buffer_rsrc_t r, unsigned byte_off, v4u v) { __builtin_amdgcn_raw_buffer_store_b128(v, r, (int)byte_off, 0, 16); }
DI v4u ld_sc1(__amdgpu_buffer_rsrc_t r, unsigned byte_off) { return __builtin_amdgcn_raw_buffer_load_b128(r, (int)byte_off, 0, 16); }

DI int chunk_of_raw(unsigned rq);
DI void chunk_prep_item(const Ctx& c, int ci, unsigned epoch, unsigned pend) {
    const Tid t_ = get_tid(); const int tid = t_.tid, lane = t_.lane, wave = t_.wave;
    const int bh = ci / NCH, cidx = ci - bh * NCH, b = bh >> 3, h = bh & 7, hc = h * HD;
    LAS float* sG = (LAS float*)c.lds;
    LAS unsigned short* sQb = (LAS unsigned short*)(c.lds + 33792);
    LAS unsigned short* sKb = sQb + 64 * 136;
    LAS unsigned short* sVb = sKb + 64 * 136;
    LAS float* sTot = (LAS float*)(c.lds + 33792 + 3 * 17408);
    LAS unsigned short* sA = (LAS unsigned short*)(c.lds + 33792 + 3 * 17408 + 2048);
    LAS unsigned short* sQx = sA + 4096;
    LAS unsigned short* sKx = sQx + 136 * 136;
    const bf16* Q = (const bf16*)(c.ws + WS_Q); const bf16* K1 = (const bf16*)(c.ws + WS_K1); const bf16* V = (const bf16*)(c.ws + WS_V); const float* G = (const float*)(c.ws + WS_G);
    const __amdgpu_buffer_rsrc_t rOP = mk_rsrc(c.ws + WS_QT, RS_ALL);
#define PSTAMP(i)
    { const int t = tid >> 3, c16 = (tid & 7) * 16;
      bool valid = true; int row;
      if (cidx == 0) { valid = t >= 48; row = ROW_M0 + b * NMETA + (t - 48); } else row = b * SEQ + 64 * (cidx - 1) + t;
      v4u q0 = {0u, 0u, 0u, 0u}, q1 = q0, k0 = q0, k1 = q0, v0 = q0, v1 = q0; f32x4 g0 = {0.f, 0.f, 0.f, 0.f}, g1 = g0, g2 = g0, g3 = g0;
      if (valid) { const size_t o = (size_t)row * WA + hc + c16;
          q0 = *(const v4u*)(Q + o); q1 = *(const v4u*)(Q + o + 8); k0 = *(const v4u*)(K1 + o); k1 = *(const v4u*)(K1 + o + 8); v0 = *(const v4u*)(V + o); v1 = *(const v4u*)(V + o + 8);
          g0 = *(const f32x4*)(G + o); g1 = *(const f32x4*)(G + o + 4); g2 = *(const f32x4*)(G + o + 8); g3 = *(const f32x4*)(G + o + 12); }
      asm volatile("" ::: "memory");
      if (tid == 0) *(LAS int*)(c.lds + MISC_OFF - 32) = chunk_of_raw(pend);
      *(LAS v4u*)(sQb + t * 136 + c16) = q0; *(LAS v4u*)(sQb + t * 136 + c16 + 8) = q1;
      *(LAS v4u*)(sKb + t * 136 + c16) = k0; *(LAS v4u*)(sKb + t * 136 + c16 + 8) = k1;
      *(LAS v4u*)(sVb + t * 136 + c16) = v0; *(LAS v4u*)(sVb + t * 136 + c16 + 8) = v1;
      *(LAS f32x4*)(sG + t * 132 + c16) = g0; *(LAS f32x4*)(sG + t * 132 + c16 + 4) = g1; *(LAS f32x4*)(sG + t * 132 + c16 + 8) = g2; *(LAS f32x4*)(sG + t * 132 + c16 + 12) = g3;
      *(LAS v4u*)(sA + tid * 8) = (v4u){0u, 0u, 0u, 0u}; }
    __syncthreads(); PSTAMP(1);
    unsigned pf0 = 0u, pf1 = 0u;
    { const int nci = *(const LAS int*)(c.lds + MISC_OFF - 32);
      if (nci >= 0) { const int nbh = nci / NCH, ncx = nci - nbh * NCH, nrow0 = (nbh >> 3) * SEQ + 64 * (ncx - 1), nhc = (nbh & 7) * HD;
#pragma unroll
          for (int rep = 0; rep < 2; ++rep) { const int L = tid + NTHR * rep;
              if (L < 640) { const int t = L / 10, part = L - 10 * t; const size_t e = (size_t)(nrow0 + t) * WA + nhc;
                  const char* p = part < 6 ? (const char*)(part < 2 ? Q : (part < 4 ? K1 : V)) + e * 2 + (part & 1) * 128 : (const char*)G + e * 4 + (part - 6) * 128;
                  const unsigned v_ = *(const unsigned*)p; if (rep == 0) pf0 = v_; else pf1 = v_; } } } }
    { const int k = tid & 127, seg = tid >> 7; float run = 0.f;
#pragma unroll
      for (int i = 0; i < 16; ++i) { const int idx = (16 * seg + i) * 132 + k; run += sG[idx]; sG[idx] = run; }
      sTot[seg * 128 + k] = run; }
    __syncthreads();
    { const int k = tid & 127, seg = tid >> 7; float off = 0.f;
      for (int s = 0; s < seg; ++s) off += sTot[s * 128 + k];
      if (seg > 0) {
#pragma unroll
          for (int i = 0; i < 16; ++i) sG[(16 * seg + i) * 132 + k] += off; } }
    __syncthreads(); PSTAMP(2);
    { const int t = tid >> 3, gi = tid & 7; float qv[16];
      unpack8(*(const LAS v4u*)(sQb + t * 136 + 16 * gi), qv); unpack8(*(const LAS v4u*)(sQb + t * 136 + 16 * gi + 8), qv + 8);
      float e[16];
#pragma unroll
      for (int j4 = 0; j4 < 4; ++j4) { const f32x4 gg = *(const LAS f32x4*)(sG + t * 132 + 16 * gi + 4 * j4);
#pragma unroll
          for (int x = 0; x < 4; ++x) e[4 * j4 + x] = qv[4 * j4 + x] * __expf(gg[x]); }
      v4u w0, w1;
      w0.x = cvtpk(e[0], e[1]); w0.y = cvtpk(e[2], e[3]); w0.z = cvtpk(e[8], e[9]); w0.w = cvtpk(e[10], e[11]);
      w1.x = cvtpk(e[4], e[5]); w1.y = cvtpk(e[6], e[7]); w1.z = cvtpk(e[12], e[13]); w1.w = cvtpk(e[14], e[15]);
      const unsigned dst = (unsigned)(((ci * 64 + t) * 128 + 16 * gi) * 2);
      st_sc1(rOP, dst, w0); st_sc1(rOP, dst + 16, w1);
      if (tid < 32) { const f32x4 gg = *(const LAS f32x4*)(sG + 63 * 132 + 4 * tid); v4u d; d.x = __float_as_uint(__expf(gg.x)); d.y = __float_as_uint(__expf(gg.y)); d.z = __float_as_uint(__expf(gg.z)); d.w = __float_as_uint(__expf(gg.w));
          st_sc1(rOP, RO_DG + (unsigned)((ci * 128 + 4 * tid) * 4), d); } }
    PSTAMP(6);
    { const int k = tid & 127, sg = tid >> 7; const float gl = sG[63 * 132 + k]; float e[16], vv[16];
#pragma unroll
      for (int j = 0; j < 16; ++j) { const int s = 16 * sg + j; e[j] = bf2f(sKb[s * 136 + k]) * __expf(gl - sG[s * 132 + k]); vv[j] = bf2f(sVb[s * 136 + k]); }
      v4u w0, w1;
      w0.x = cvtpk(e[0], e[1]); w0.y = cvtpk(e[2], e[3]); w0.z = cvtpk(e[4], e[5]); w0.w = cvtpk(e[6], e[7]);
      w1.x = cvtpk(e[8], e[9]); w1.y = cvtpk(e[10], e[11]); w1.z = cvtpk(e[12], e[13]); w1.w = cvtpk(e[14], e[15]);
      LAS unsigned char* stK = (LAS unsigned char*)sQx; LAS unsigned char* stV = stK + 128 * 144;
      *(LAS v4u*)(stK + k * 144 + 32 * sg) = w0; *(LAS v4u*)(stK + k * 144 + 32 * sg + 16) = w1;
      w0.x = cvtpk(vv[0], vv[1]); w0.y = cvtpk(vv[2], vv[3]); w0.z = cvtpk(vv[4], vv[5]); w0.w = cvtpk(vv[6], vv[7]);
      w1.x = cvtpk(vv[8], vv[9]); w1.y = cvtpk(vv[10], vv[11]); w1.z = cvtpk(vv[12], vv[13]); w1.w = cvtpk(vv[14], vv[15]);
      *(LAS v4u*)(stV + k * 144 + 32 * sg) = w0; *(LAS v4u*)(stV + k * 144 + 32 * sg + 16) = w1;
      __syncthreads();
#pragma unroll
      for (int i = 0; i < 2; ++i) { const int p = tid + NTHR * i; const unsigned go = (unsigned)((ci * 1024 + p) * 16);
          st_sc1(rOP, RO_KH + go, *(const LAS v4u*)(stK + (p >> 3) * 144 + (p & 7) * 16)); st_sc1(rOP, RO_VT + go, *(const LAS v4u*)(stV + (p >> 3) * 144 + (p & 7) * 16)); }
      __syncthreads(); }
    PSTAMP(7);
#pragma unroll 7
    for (int task = tid; task < 208 * 16; task += NTHR) {
        const int rowx = task >> 4, kg = (task & 15) * 8;
        int t, rf; bool isq = rowx < 128;
        if (rowx < 96) { const int j = rowx < 48 ? 0 : (rowx < 80 ? 1 : 2); t = rowx < 48 ? 16 + rowx : (rowx < 80 ? rowx - 16 : rowx - 32); rf = 16 * j + 15; }
        else if (rowx < 128) { const int bb = (rowx - 96) >> 3, i = (rowx - 96) & 7; t = 16 * bb + 8 + i; rf = 16 * bb + 7; }
        else if (rowx < 176) { t = rowx - 128; rf = (t & ~15) + 15; }
        else { const int bb = (rowx - 176) >> 3, i = (rowx - 176) & 7; t = 16 * bb + i; rf = 16 * bb + 7; }
        float xv[8]; unpack8(*(const LAS v4u*)((isq ? sQb : sKb) + t * 136 + kg), xv);
        const f32x4 a0 = *(const LAS f32x4*)(sG + t * 132 + kg), a1 = *(const LAS f32x4*)(sG + t * 132 + kg + 4);
        const f32x4 r0 = *(const LAS f32x4*)(sG + rf * 132 + kg), r1 = *(const LAS f32x4*)(sG + rf * 132 + kg + 4);
        const float sgn = isq ? 1.0f : -1.0f; float e[8];
#pragma unroll
        for (int x = 0; x < 4; ++x) { e[x] = xv[x] * __expf(sgn * (a0[x] - r0[x])); e[4 + x] = xv[4 + x] * __expf(sgn * (a1[x] - r1[x])); }
        v4u w; w.x = cvtpk(e[0], e[1]); w.y = cvtpk(e[2], e[3]); w.z = cvtpk(e[4], e[5]); w.w = cvtpk(e[6], e[7]);
        *(LAS v4u*)((isq ? sQx + rowx * 136 : sKx + (rowx - 128) * 136) + kg) = w;
    }
    __syncthreads(); PSTAMP(3);
    for (int tile = wave; tile < 10; tile += NWAVES) {
        const int fr = lane & 15, fq = lane >> 4;
        int qrow, krow_, orow, ocol; bool small = tile >= 6;
        if (!small) { const int bi = tile < 3 ? tile + 1 : (tile < 5 ? tile - 1 : 3), bj = tile < 3 ? 0 : (tile < 5 ? 1 : 2);
            qrow = (bj == 0 ? 0 : (bj == 1 ? 48 : 80)) + 16 * (bi - bj - 1); krow_ = 16 * bj; orow = 16 * bi; ocol = 16 * bj; }
        else { const int bb = tile - 6; qrow = 96 + 8 * bb; krow_ = 48 + 8 * bb; orow = 16 * bb + 8; ocol = 16 * bb; }
        f32x4 acc = {0.f, 0.f, 0.f, 0.f};
#pragma unroll
        for (int ks = 0; ks < 4; ++ks) {
            const bf16x8 a = *(const LAS bf16x8*)(sQx + (qrow + fr) * 136 + 32 * ks + 8 * fq);
            const bf16x8 bb = *(const LAS bf16x8*)(sKx + (krow_ + fr) * 136 + 32 * ks + 8 * fq);
            acc = __builtin_amdgcn_mfma_f32_16x16x32_bf16(a, bb, acc, 0, 0, 0); }
        if (!small) {
#pragma unroll
            for (int i = 0; i < 4; ++i) sA[(orow + 4 * fq + i) * 64 + ocol + fr] = (unsigned short)(cvtpk(acc[i], 0.f) & 0xffffu); }
        else if (fq < 2 && fr < 8) {
#pragma unroll
            for (int i = 0; i < 4; ++i) sA[(orow + 4 * fq + i) * 64 + ocol + fr] = (unsigned short)(cvtpk(acc[i], 0.f) & 0xffffu); }
    }
    PSTAMP(8);
    { const int kp = tid & 15, grp = tid >> 4, blk = grp >> 2, tp = grp & 3, t0 = 8 * blk + tp, t1 = 8 * blk + 7 - tp;
      v2u q0[2], q1[2]; f32x4 g0[2], g1[2];
#pragma unroll
      for (int hf = 0; hf < 2; ++hf) { const int k4 = 64 * hf + 4 * kp;
          q0[hf] = *(const LAS v2u*)(sQb + t0 * 136 + k4); g0[hf] = *(const LAS f32x4*)(sG + t0 * 132 + k4);
          q1[hf] = *(const LAS v2u*)(sQb + t1 * 136 + k4); g1[hf] = *(const LAS f32x4*)(sG + t1 * 132 + k4); }
#pragma unroll 3
      for (int i = 0; i < 9; ++i) {
          const bool fst = i <= tp; const int t = fst ? t0 : t1, s = 8 * blk + (fst ? i : i - tp - 1);
          float a = 0.f;
#pragma unroll
          for (int hf = 0; hf < 2; ++hf) { const int k4 = 64 * hf + 4 * kp;
              const v2u qw = fst ? q0[hf] : q1[hf], kw = *(const LAS v2u*)(sKb + s * 136 + k4);
              const f32x4 gt = fst ? g0[hf] : g1[hf], gs = *(const LAS f32x4*)(sG + s * 132 + k4);
              a += bflo(qw.x) * bflo(kw.x) * __expf(gt.x - gs.x); a += bfhi(qw.x) * bfhi(kw.x) * __expf(gt.y - gs.y);
              a += bflo(qw.y) * bflo(kw.y) * __expf(gt.z - gs.z); a += bfhi(qw.y) * bfhi(kw.y) * __expf(gt.w - gs.w); }
          a = row16_sum(a);
          if (kp == 0) sA[t * 64 + s] = (unsigned short)(cvtpk(a, 0.f) & 0xffffu);
      } }
    __syncthreads(); PSTAMP(4);
    st_sc1(rOP, RO_AM + (unsigned)((ci * 4096 + tid * 8) * 2), *(const LAS v4u*)(sA + tid * 8));
    asm volatile("s_waitcnt vmcnt(0)" ::: "memory");
    __syncthreads();
    if (tid == 0) __hip_atomic_store((unsigned*)(c.ws + WS_CTL) + CW_FLAG + ci * FLAG_STRIDE, epoch, RLX_AGENT);
    asm volatile("" :: "v"(pf0), "v"(pf1));
}

DI bool wait_flag(unsigned* flag, unsigned want, unsigned* tmo) {
    for (unsigned spins = 0;;) {
        if ((unsigned)__builtin_amdgcn_readfirstlane(__hip_atomic_load(flag, RLX_AGENT)) >= want) return true;
        __builtin_amdgcn_s_sleep(2);
        if (++spins > (1u << 22)) { __hip_atomic_store(tmo, 1u, RLX_AGENT); return false; }
    }
}
DI int ensure_ready(unsigned* flags0, int cc, int ready_upto, unsigned epoch, unsigned* tmo, int lane) {
    unsigned spins = 0;
    while (ready_upto < cc) {
        const int cq = ready_upto + 1 + (lane & 15);
        const unsigned v = cq < NCH ? __hip_atomic_load(flags0 + cq * FLAG_STRIDE, RLX_AGENT) : epoch;
        const unsigned m = (unsigned)(__ballot(v >= epoch) & 0xffffull);
        const int n = __builtin_ctz(~m | 0x10000u);
        if (n > 0) ready_upto += n;
        else { __builtin_amdgcn_s_sleep(2); if (++spins > (1u << 22)) { __hip_atomic_store(tmo, 1u, RLX_AGENT); return cc; } }
    }
    return ready_upto;
}
DI void hgrn_scan(const Ctx& c, int l, int bh) {
    const Tid t_ = get_tid(); const int tid = t_.tid, lane = t_.lane, wave = t_.wave;
    const int b = bh >> 3, h = bh & 7, hc = h * HD;
    constexpr int OB = 64000, O_KH = 17408, O_VT = 35840, O_AM = 54272, O_D = 63488, OO = 2 * OB, OOB = 64 * 272;
    LAS float* sNW = (LAS float*)(c.lds + OO + 2 * OOB);
    if (tid < HD) sNW[tid] = c.hgrn_nw[l * HD + tid];
    const bf16* ZA = (const bf16*)(c.ws + WS_ZA); bf16* X = (bf16*)(c.ws + WS_X);
    const int nrow = tid >> 4, vg = tid & 15;
    v4u pz[2];
#define SCAN_LOAD_ZA(cc) do { if ((cc) < NCH) { _Pragma("unroll") for (int i = 0; i < 2; ++i) { \
            const int rr_ = nrow + 32 * i; const int grow_ = (cc) == 0 ? ROW_M0 + b * NMETA + rr_ - 48 : b * SEQ + 64 * ((cc) - 1) + rr_; \
            pz[i] = ((cc) == 0 && rr_ < 48) ? (v4u){0u, 0u, 0u, 0u} : *(const v4u*)(ZA + (size_t)grow_ * WA + hc + 8 * vg); } } } while (0)
#define SCAN_NORM(cc) do { if ((cc) >= 0) { const LAS unsigned char* so_ = c.lds + OO + ((cc) & 1) * OOB; _Pragma("unroll") for (int i = 0; i < 2; ++i) { const int rr = nrow + 32 * i; \
            float o[8]; unpack8(*(const LAS v4u*)(so_ + rr * 272 + vg * 16), o); \
            float ss = (o[0] * o[0] + o[1] * o[1]) + (o[2] * o[2] + o[3] * o[3]) + (o[4] * o[4] + o[5] * o[5]) + (o[6] * o[6] + o[7] * o[7]); \
            ss = row16_sum(ss); \
            const float rs = __builtin_amdgcn_rsqf(ss * (1.0f / HD) + EPS); \
            float z[8]; unpack8(pz[i], z); const f32x4 n0 = *(const LAS f32x4*)(sNW + 8 * vg), n1 = *(const LAS f32x4*)(sNW + 8 * vg + 4); \
            v4u w; w.x = cvtpk(o[0] * rs * n0.x * z[0], o[1] * rs * n0.y * z[1]); w.y = cvtpk(o[2] * rs * n0.z * z[2], o[3] * rs * n0.w * z[3]); \
            w.z = cvtpk(o[4] * rs * n1.x * z[4], o[5] * rs * n1.y * z[5]); w.w = cvtpk(o[6] * rs * n1.z * z[6], o[7] * rs * n1.w * z[7]); \
            if ((cc) > 0 || rr >= 48) { const int grow = (cc) == 0 ? ROW_M0 + b * NMETA + rr - 48 : b * SEQ + 64 * ((cc) - 1) + rr; \
                *(v4u*)(X + (size_t)grow * DM + hc + 8 * vg) = w; } \
            asm volatile("" ::: "memory"); } } } while (0)
    if (wave >= 4) {
        const __amdgpu_buffer_rsrc_t rOP = mk_rsrc(c.ws + WS_QT, RS_ALL);
        unsigned* flags = (unsigned*)(c.ws + WS_CTL) + CW_FLAG; unsigned* tmo = (unsigned*)(c.ws + WS_CTL) + 8;
        const unsigned epoch = (unsigned)l + 1u;
        const int lt0 = tid - 256;
        v4u aq[4], ak[4], av[4], aa[2], ad, bq[4], bk[4], bv[4], ba[2], bd, cq[4], ck[4], cv[4], ca[2], cd;
        int ready_upto = -1;
#define PWAIT_BEGIN
#define PWAIT_END
#define SCAN_ISSUE(cc, Q_, K_, V_, A_, D_) do { if ((cc) < NCH) { const int ci_ = bh * NCH + (cc); int lt = lt0; asm volatile("" : "+v"(lt)); \
            PWAIT_BEGIN; ready_upto = ensure_ready(flags + bh * NCH * FLAG_STRIDE, (cc), ready_upto, epoch, tmo, lane); PWAIT_END; \
            _Pragma("unroll") for (int i = 0; i < 4; ++i) { const unsigned o_ = (unsigned)((ci_ * 1024 + lt + 256 * i) * 16); Q_[i] = ld_sc1(rOP, o_); K_[i] = ld_sc1(rOP, RO_KH + o_); V_[i] = ld_sc1(rOP, RO_VT + o_); } \
            _Pragma("unroll") for (int i = 0; i < 2; ++i) A_[i] = ld_sc1(rOP, RO_AM + (unsigned)((ci_ * 512 + lt + 256 * i) * 16)); \
            D_ = lt < 32 ? ld_sc1(rOP, RO_DG + (unsigned)((ci_ * 32 + lt) * 16)) : (v4u){0u, 0u, 0u, 0u}; } } while (0)
#define SCAN_STAGE(cc, Q_, K_, V_, A_, D_) do { if ((cc) < NCH) { LAS unsigned char* ob_ = c.lds + ((cc) & 1) * OB; int lt = lt0; asm volatile("" : "+v"(lt));     \
            _Pragma("unroll") for (int i = 0; i < 4; ++i) { const int p = lt + 256 * i; \
                *(LAS v4u*)(ob_ + (p >> 4) * 272 + (p & 15) * 16) = Q_[i]; \
                *(LAS v4u*)(ob_ + O_KH + (p >> 3) * 144 + (p & 7) * 16) = K_[i]; \
                *(LAS v4u*)(ob_ + O_VT + (p >> 3) * 144 + (p & 7) * 16) = V_[i]; } \
            _Pragma("unroll") for (int i = 0; i < 2; ++i) { const int p = lt + 256 * i; *(LAS v4u*)(ob_ + O_AM + (p >> 3) * 144 + (p & 7) * 16) = A_[i]; } \
            if (lt < 32) *(LAS v4u*)(ob_ + O_D + lt * 16) = D_; } } while (0)
#define SCAN_STEP(cc, Q_, K_, V_, A_, D_) do { if ((cc) < NCH) { \
            SCAN_NORM((cc) - 1); SCAN_LOAD_ZA(cc); \
            SCAN_STAGE((cc) + 1, Q_, K_, V_, A_, D_); SCAN_ISSUE((cc) + 4, Q_, K_, V_, A_, D_); \
            __syncthreads(); } } while (0)
        SCAN_ISSUE(0, aq, ak, av, aa, ad); SCAN_ISSUE(1, bq, bk, bv, ba, bd); SCAN_ISSUE(2, cq, ck, cv, ca, cd);
        SCAN_STAGE(0, aq, ak, av, aa, ad); SCAN_ISSUE(3, aq, ak, av, aa, ad);
        __syncthreads();
#pragma unroll 1
        for (int cc = 0; cc < NCH; cc += 3) {
            SCAN_STEP(cc, bq, bk, bv, ba, bd);
            SCAN_STEP(cc + 1, cq, ck, cv, ca, cd);
            SCAN_STEP(cc + 2, aq, ak, av, aa, ad);
        }
        SCAN_NORM(NCH - 1);
#undef SCAN_STEP
#undef SCAN_ISSUE
#undef SCAN_STAGE
    } else {
        __builtin_amdgcn_s_setprio(1);
        const int r = lane & 31, hh = lane >> 5, vs = wave;
        f32x16 S[4];
#pragma unroll
        for (int kt = 0; kt < 4; ++kt)
#pragma unroll
            for (int i = 0; i < 16; ++i) S[kt][i] = 0.f;
        __syncthreads();
#pragma unroll 1
        for (int cc = 0; cc < NCH; ++cc) {
            SCAN_NORM(cc - 1); SCAN_LOAD_ZA(cc);
            LAS unsigned short* sO = (LAS unsigned short*)(c.lds + OO + (cc & 1) * OOB) + 32 * vs + r;
            LAS unsigned char* sQT = c.lds + (cc & 1) * OB; LAS unsigned char* sKH = sQT + O_KH; LAS unsigned char* sVT = sQT + O_VT; LAS unsigned char* sAM = sQT + O_AM; LAS float* sD = (LAS float*)(sQT + O_D);
            const LAS unsigned char* pAM = sAM + r * 144 + hh * 16; const LAS unsigned char* pQT = sQT + r * 272 + hh * 16; const LAS unsigned char* pKH = sKH + r * 144 + hh * 16;
#define LDSW() do { asm volatile("s_waitcnt lgkmcnt(0)" ::: "memory"); __builtin_amdgcn_sched_barrier(0); } while (0)
#define LDF(p) (*(const LAS bf16x8*)(p))
#define LDD(dst, kt) do { _Pragma("unroll") for (int g = 0; g < 4; ++g) dst[g] = *(const LAS f32x4*)(sD + 32 * (kt) + 8 * g + 4 * hh); } while (0)
#define SCALE(kt, dsrc) do { _Pragma("unroll") for (int g = 0; g < 4; ++g) _Pragma("unroll") for (int e = 0; e < 4; ++e) S[kt][4 * g + e] *= dsrc[g][e]; } while (0)
#define MF(a, b, c) __builtin_amdgcn_mfma_f32_32x32x16_bf16((a), (b), (c), 0, 0, 0)
#define LD4(dst, p) do { _Pragma("unroll") for (int i = 0; i < 4; ++i) dst[i] = LDF((p) + 32 * i); } while (0)
#define WRO(ov, rbase) do { _Pragma("unroll") for (int i = 0; i < 16; i += 2) { const unsigned w_ = cvtpk(ov[i], ov[i + 1]); sO[((rbase) + crow(i, hh)) * 136] = (unsigned short)(w_ & 0xffffu); sO[((rbase) + crow(i + 1, hh)) * 136] = (unsigned short)(w_ >> 16); } } while (0)
            bf16x8 vf[4], fa[4], fb[4]; f32x4 dd[4];
#pragma unroll
            for (int ss = 0; ss < 4; ++ss) vf[ss] = LDF(sVT + (32 * vs + r) * 144 + (16 * ss + 8 * hh) * 2);
            LD4(fa, pAM);
            bf16x8 sb[8];
#pragma unroll
            for (int ks = 0; ks < 8; ++ks) { const int kt = ks >> 1, s8 = (ks & 1) * 8; v4u w;
                w.x = cvtpk(S[kt][s8 + 0], S[kt][s8 + 1]); w.y = cvtpk(S[kt][s8 + 2], S[kt][s8 + 3]); w.z = cvtpk(S[kt][s8 + 4], S[kt][s8 + 5]); w.w = cvtpk(S[kt][s8 + 6], S[kt][s8 + 7]);
                sb[ks] = __builtin_bit_cast(bf16x8, w); }
            LDSW();
            LD4(fb, pQT);
            f32x16 o0;
#pragma unroll
            for (int i = 0; i < 16; ++i) o0[i] = 0.f;
#pragma unroll
            for (int i = 0; i < 4; ++i) o0 = MF(fa[i], vf[i], o0);
            LDSW();
            LD4(fa, pQT + 128);
#pragma unroll
            for (int i = 0; i < 4; ++i) o0 = MF(fb[i], sb[i], o0);
            LDSW();
            LD4(fb, pAM + 32 * 144);
#pragma unroll
            for (int i = 0; i < 4; ++i) o0 = MF(fa[i], sb[4 + i], o0);
            WRO(o0, 0);
            LDSW();
            LD4(fa, pQT + 32 * 272);
            f32x16 o1;
#pragma unroll
            for (int i = 0; i < 16; ++i) o1[i] = 0.f;
#pragma unroll
            for (int i = 0; i < 4; ++i) o1 = MF(fb[i], vf[i], o1);
            LDSW();
            LD4(fb, pQT + 32 * 272 + 128);
#pragma unroll
            for (int i = 0; i < 4; ++i) o1 = MF(fa[i], sb[i], o1);
            LDSW();
            LD4(fa, pKH); LDD(dd, 0);
#pragma unroll
            for (int i = 0; i < 4; ++i) o1 = MF(fb[i], sb[4 + i], o1);
            WRO(o1, 32);
            LDSW();
            SCALE(0, dd);
            LD4(fb, pKH + 32 * 144); LDD(dd, 1);
#pragma unroll
            for (int i = 0; i < 4; ++i) S[0] = MF(fa[i], vf[i], S[0]);
            LDSW();
            SCALE(1, dd);
            LD4(fa, pKH + 64 * 144); LDD(dd, 2);
#pragma unroll
            for (int i = 0; i < 4; ++i) S[1] = MF(fb[i], vf[i], S[1]);
            LDSW();
            SCALE(2, dd);
            LD4(fb, pKH + 96 * 144); LDD(dd, 3);
#pragma unroll
            for (int i = 0; i < 4; ++i) S[2] = MF(fa[i], vf[i], S[2]);
            LDSW();
            SCALE(3, dd);
#pragma unroll
            for (int i = 0; i < 4; ++i) S[3] = MF(fb[i], vf[i], S[3]);
#undef LD4
#undef WRO
#undef LDSW
#undef LDF
#undef LDD
#undef SCALE
#undef MF
            __syncthreads();
        }
        SCAN_NORM(NCH - 1);
        float* So = c.out + O_SHP + (((size_t)l * BATCH + b) * NH + h) * (size_t)(HD * HD);
#pragma unroll
        for (int kt = 0; kt < 4; ++kt)
#pragma unroll
            for (int i = 0; i < 16; ++i) So[(size_t)(32 * kt + crow(i, hh)) * HD + 32 * vs + r] = S[kt][i];
        __builtin_amdgcn_s_setprio(0);
    }
#undef SCAN_LOAD_ZA
#undef SCAN_NORM
    __syncthreads();
}

struct OneUnit { int pm, pn;
    __device__ __forceinline__ bool next(int i, pg8::Unit& u) const { if (i) return false; u.pm = pm; u.pn = pn; return true; }
    __device__ __forceinline__ void a_ready(const pg8::Unit&) const {}
    __device__ __forceinline__ void done(const pg8::Unit&) const {} };
DI void publish_count(unsigned* word) {
    asm volatile("s_waitcnt vmcnt(0)" ::: "memory");
    __syncthreads();
    if (threadIdx.x == 0) __hip_atomic_fetch_add(word, 1u, RLX_AGENT);
}
DI void wait_count_acquire(unsigned* word, unsigned need, unsigned* tmo) {
    if (threadIdx.x < 64) { wait_flag(word, need, tmo); __builtin_amdgcn_fence(__ATOMIC_ACQUIRE, "agent"); asm volatile("s_waitcnt vmcnt(0)" ::: "memory"); }
    __syncthreads();
}
constexpr int CW_QUEUE = 2048;
constexpr int QI_ILV = 8, SCAN_OWN = 2;
constexpr int QI_CHUNK = NCI, QI_SAMPLE = DECB * NH, QI_CONVX = (M_ROWS - ROW_S0 + 31) / 32, QI_CONV = QI_CONVX + 16  , QI_DEFER = 96, QI_HEAD = 7 * (32 + QI_ILV);
constexpr int CW_DEFER = 9216;
static_assert(PREP_ITEMS % 16 == 0 && PREP_I_OUT % 16 == 0 && PREP_I_IN % 16 == 0, "prep items");
struct QPop { unsigned* qword; volatile LAS unsigned* slot; unsigned pending; int it; };
DI QPop q_begin(unsigned* qword, volatile LAS unsigned* slot) { QPop q; q.qword = qword; q.slot = slot; q.it = 0; q.pending = 0u;
    if (threadIdx.x == 0) q.pending = __hip_atomic_fetch_add(qword, 1u, RLX_AGENT); return q; }
DI int q_next(QPop& q) {
    volatile LAS unsigned* sl = q.slot + (q.it & 1); q.it ^= 1;
    if (threadIdx.x == 0) *sl = q.pending;
    __syncthreads();
    const int idx = __builtin_amdgcn_readfirstlane((int)*sl);
    if (threadIdx.x == 0) q.pending = __hip_atomic_fetch_add(q.qword, 1u, RLX_AGENT);
    return idx;
}
constexpr unsigned Q_NONE = 0xffffffffu;
DI QPop q_begin_hold(unsigned* qword, volatile LAS unsigned* slot) { QPop q; q.qword = qword; q.slot = slot; q.it = 0; q.pending = Q_NONE; return q; }
DI int q_next_hold(QPop& q, int hold_lo, int hold_hi) {
    volatile LAS unsigned* sl = q.slot + (q.it & 1); q.it ^= 1;
    if (threadIdx.x == 0) *sl = q.pending != Q_NONE ? q.pending : __hip_atomic_fetch_add(q.qword, 1u, RLX_AGENT);
    __syncthreads();
    const int idx = __builtin_amdgcn_readfirstlane((int)*sl);
    if (threadIdx.x == 0) q.pending = (idx < hold_lo || idx >= hold_hi) ? __hip_atomic_fetch_add(q.qword, 1u, RLX_AGENT) : Q_NONE;
    return idx;
}
DI int chunk_of_raw(unsigned rq) {
    if (rq == Q_NONE) return -1;
    const int r = (int)rq, raw0 = r < QI_HEAD ? r + QI_DEFER : (r < QI_HEAD + QI_DEFER ? r - QI_HEAD : r);
    if (raw0 < QI_DEFER) return -1;
    const int raw = raw0 - QI_DEFER;
    if (raw >= (NCH - SCAN_OWN) * (32 + QI_ILV)) return -1;
    const int blk = raw / (32 + QI_ILV), r_ = raw - blk * (32 + QI_ILV);
    if (r_ >= 32) return -1;
    const int idx = (blk + SCAN_OWN) * 32 + r_;
    return (idx & 31) * NCH + (idx >> 5);
}
DI void phase_mixer(const Ctx& c, int l) {
    constexpr int NSCAN = BATCH * NH;
    const unsigned epoch = (unsigned)l + 1u;
    const int n_prep = (l + 1 < DEPTH ? PREP_ITEMS / 16 : 0), n_prep0 = (l == 0 ? PREP_I_OUT / 16 : 0);
    const int QI_P0 = QI_CHUNK + QI_SAMPLE, QI_C0 = QI_P0 + n_prep + n_prep0, QI_TOTAL = QI_C0 + QI_CONV;
    unsigned* qw = (unsigned*)(c.ws + WS_CTL) + CW_QUEUE + 16 * l;
    unsigned* du = (unsigned*)(c.ws + WS_CTL) + CW_DEFER; unsigned* tmo = (unsigned*)(c.ws + WS_CTL) + 8;
    bool have_du = false;
    volatile LAS unsigned* slot = (volatile LAS unsigned*)(c.lds + MISC_OFF) + 16;
    if (c.vcu < NSCAN) { for (int k = 0; k < SCAN_OWN; ++k) { chunk_prep_item(c, c.vcu * NCH + k, epoch, 0xffffffffu); __syncthreads(); } hgrn_scan(c, l, c.vcu); }
    QPop qp = q_begin_hold(qw, slot);
    for (;;) {
        const int rawq = q_next_hold(qp, QI_HEAD, QI_HEAD + QI_DEFER);
        const int raw0 = rawq < QI_HEAD ? rawq + QI_DEFER : (rawq < QI_HEAD + QI_DEFER ? rawq - QI_HEAD : rawq);
        if (raw0 < QI_DEFER) {
            const pg8::Gemm g{(const pg8::bf16_t*)(c.ws + WS_HN), (const pg8::bf16_t*)(c.ws + WS_WIN) + (size_t)l * DIN * DM, M_PAD, DIN, DM, DM};
            const pg8::EpiInProj E{c.ws, l, 0};
            OneUnit O{29 + raw0 / 16, 16 + raw0 % 16};
            pg8::gemm_phase<pg8::EpiInProj, OneUnit, true, true>(c.lds, g, O, E);
            asm volatile("s_waitcnt vmcnt(0)" ::: "memory");
            __syncthreads();
            if (threadIdx.x == 0) { __builtin_amdgcn_fence(__ATOMIC_RELEASE, "agent"); __hip_atomic_fetch_add(du, 1u, RLX_AGENT); }
            continue; }
        const int raw = raw0 - QI_DEFER;
        int idx = raw;
        if (raw < (NCH - SCAN_OWN) * (32 + QI_ILV)) { const int blk = raw / (32 + QI_ILV), r_ = raw - blk * (32 + QI_ILV); idx = r_ < 32 ? (blk + SCAN_OWN) * 32 + r_ : QI_CHUNK + blk * QI_ILV + (r_ - 32); }
        else { const int r2 = raw - (NCH - SCAN_OWN) * (32 + QI_ILV);
            if (r2 < QI_CONV) idx = QI_C0 + r2;
            else if (r2 < QI_CONV + n_prep + n_prep0) idx = QI_P0 + (r2 - QI_CONV);
            else { idx = QI_CHUNK + (NCH - SCAN_OWN) * QI_ILV + (r2 - QI_CONV - n_prep - n_prep0); if (idx >= QI_P0) idx = QI_TOTAL; } }
        if (idx >= QI_TOTAL) break;
#ifndef REP_K
#define REP_K 1
#endif
#ifndef REP_S
#define REP_S 1
#endif
#ifndef REP_V
#define REP_V 1
#endif
        if (idx < QI_CHUNK) { const int cc = idx >> 5, bh = idx & 31; for (int rep = 0; rep < REP_K; ++rep) { chunk_prep_item(c, bh * NCH + cc, epoch, qp.pending); __syncthreads(); } }
        else if (idx < QI_CHUNK + QI_SAMPLE) { for (int rep = 0; rep < REP_S; ++rep) hgrn_sample_item(c, l, idx - QI_CHUNK); }
        else if (idx < QI_C0) { const int j = idx - QI_P0;
            if (j < n_prep) prep_layer(c, l + 1, j * 16, j * 16 + 16, NWAVES); else prep_layer(c, 0, PREP_I_IN + (j - n_prep) * 16, PREP_I_IN + (j - n_prep) * 16 + 16, NWAVES);
            __syncthreads(); }
        else { const int j = idx - QI_C0;
            if (!have_du) { wait_count_acquire(du, (unsigned)QI_DEFER * epoch, tmo); have_du = true; }
            if (j < QI_CONVX) phase_conv(c, l, ROW_S0 / 32 + j, 0); else phase_conv(c, l, j - QI_CONVX, -1); }
    }
}

constexpr int CW_CCNT = 3072;
constexpr int NB_ROWS = 16, QN_BLOCKS = M_ROWS / NB_ROWS, QN_EXTRA_UNITS = 3 * 8 * 4;
static_assert(M_ROWS % NB_ROWS == 0, "norm blocks");
DI void wait_main_counts_acquire(unsigned* ccnt, unsigned need, unsigned* tmo) {
    if (threadIdx.x < 64) { const int lane = threadIdx.x;
        for (unsigned spins = 0;;) { const unsigned v = lane < ROW_S0 / 256 ? __hip_atomic_load(ccnt + 16 * lane, RLX_AGENT) : need;
            if (__all(v >= need)) break;
            __builtin_amdgcn_s_sleep(2);
            if (++spins > (1u << 22)) { __hip_atomic_store(tmo, 1u, RLX_AGENT); break; } }
        __builtin_amdgcn_fence(__ATOMIC_ACQUIRE, "agent"); asm volatile("s_waitcnt vmcnt(0)" ::: "memory"); }
    __syncthreads();
}
DI void phase_outproj_norm(const Ctx& c, int l) {
    unsigned* ctl = (unsigned*)(c.ws + WS_CTL); unsigned* tmo = ctl + 8;
    const pg8::Gemm g{(const pg8::bf16_t*)(c.ws + WS_X), (const pg8::bf16_t*)(c.ws + WS_WOUT) + (size_t)l * DM * DM, M_PAD, DM, DM, DM};
    const pg8::EpiMix E{(pg8::bf16_t*)(c.ws + WS_MIX)};
    { pg8::StaticOrder S; S.init(ROW_S0, DM, c.G, (int)blockIdx.x);
      pg8::Unit u;
      for (int i = 0; S.next(i, u); ++i) { OneUnit O{u.pm, u.pn}; pg8::gemm_phase<pg8::EpiMix, OneUnit, true, true>(c.lds, g, O, E); publish_count(ctl + CW_CCNT + 16 * u.pm); } }
    unsigned* qw = ctl + CW_QUEUE + 16 * (DEPTH + l);
    volatile LAS unsigned* slot = (volatile LAS unsigned*)(c.lds + MISC_OFF) + 16;
    const unsigned need = 8u * (unsigned)(l + 1);
    int have = -1; bool have_main = false;
    QPop qp = q_begin(qw, slot);
    for (;;) {
        const int idx = q_next(qp);
        if (idx >= QN_EXTRA_UNITS + QN_BLOCKS) break;
        if (l == DEPTH - 1 && (idx < QN_EXTRA_UNITS ? (idx >> 2) / 8 == (ROW_M0 - ROW_S0) / 256 : (idx - QN_EXTRA_UNITS) * NB_ROWS >= ROW_M0)) continue;
        if (idx < QN_EXTRA_UNITS) {
            const int kq = idx & 3, un = idx >> 2; OneUnit O{ROW_S0 / 256 + un / 8, un % 8};
            const pg8::Gemm gq{g.A + kq * (DM / 4), g.Bt + kq * (DM / 4), M_PAD, DM, DM / 4, DM};
            const pg8::EpiMix Eq{(pg8::bf16_t*)(c.ws + WS_MIXP) + ((size_t)kq * XROWS - ROW_S0) * DM};
            pg8::gemm_phase<pg8::EpiMix, OneUnit, true, true>(c.lds, gq, O, Eq); publish_count(ctl + CW_CCNT + 16 * O.pm); }
        else { const int blk = idx - QN_EXTRA_UNITS, row0 = blk * NB_ROWS, mt = row0 >> 8;
            if (mt < ROW_S0 / 256) { if (!have_main) { wait_main_counts_acquire(ctl + CW_CCNT, need, tmo); have_main = true; } }
            else if (mt != have) { wait_count_acquire(ctl + CW_CCNT + 16 * mt, 4u * need, tmo); have = mt; }
#ifndef REP_N
#define REP_N 1
#endif
            for (int rep = 1; rep < REP_N; ++rep) norm_rows(c, l + 1, row0, row0 + NB_ROWS, NWAVES, true);
            norm_rows(c, l + 1, row0, row0 + NB_ROWS, NWAVES); }
    }
}
#ifndef REP_P
#define REP_P 1
#endif
#ifndef REP_A
#define REP_A 1
#endif
#ifndef REP_B1
#define REP_B1 1
#endif
#ifndef REP_B
#define REP_B 1
#endif
#ifndef REP_C
#define REP_C 1
#endif
struct DeferOrder { pg8::StaticOrder S;
    __device__ __forceinline__ bool next(int i, pg8::Unit& u) const { if (!S.next(i, u)) return false; if (u.pm >= 29 && u.pn >= 16) { u.pm += 3; u.pn -= 16; } return true; }
    __device__ __forceinline__ void a_ready(const pg8::Unit&) const {}
    __device__ __forceinline__ void done(const pg8::Unit&) const {} };
struct Args { const float* in[12]; float* out; unsigned char* ws; int ph_lo, ph_hi; };
constexpr int N_PHASES = 1 + 3 * DEPTH;
__global__ void __launch_bounds__(NTHR, 2) fwd(Args args) {
    extern __shared__ __attribute__((aligned(16))) unsigned char lds_raw[];
    Ctx c;
    c.lds = (LAS unsigned char*)lds_raw;
    c.G = gridDim.x; { const int bx = blockIdx.x; c.vcu = (c.G % 8 == 0) ? (bx % 8) * (c.G / 8) + bx / 8 : bx; }
    c.x_prompt = args.in[0]; c.x_sample = args.in[1]; c.state_hgrn = args.in[2]; c.state_conv = args.in[3]; c.meta = args.in[4]; c.w_in = args.in[5];
    c.conv_w = args.in[6]; c.lb_param = args.in[7]; c.hgrn_nw = args.in[8]; c.w_out = args.in[9]; c.pre_w = args.in[10]; c.post_w = args.in[11];
    c.out = args.out; c.ws = args.ws;
    volatile LAS unsigned* MISC = (volatile LAS unsigned*)(c.lds + MISC_OFF);
    if (threadIdx.x < 32) ((LAS unsigned*)(c.lds + MISC_OFF))[threadIdx.x] = 0u;
    __syncthreads();
    unsigned* barw = (unsigned*)(c.ws + WS_CTL) + CW_BAR;
    const bool multi = (args.ph_hi - args.ph_lo) > 1;
    XcdBarrier bar; bar.bar = barw; bar.x = 0; bar.st = nullptr;
    if (multi) bar = xcd_barrier_post(barw, MISC + 8);

    for (int ph = args.ph_lo; ph < args.ph_hi; ++ph) {
        if (ph > args.ph_lo) xcd_barrier(bar);
#ifdef REP_BAR
        if (ph == 2) for (int rep = 0; rep < REP_BAR; ++rep) xcd_barrier(bar);
#endif
        if (ph == 0) { for (int rep = 0; rep < REP_P; ++rep) phase_prep(c); phase_norm(c, 0); continue; }
        const int l = (ph - 1) / 3, k = (ph - 1) % 3;
        if (k == 0) { for (int rep = 0; rep < REP_A; ++rep) {
            pg8::Gemm g{(const pg8::bf16_t*)(c.ws + WS_HN), (const pg8::bf16_t*)(c.ws + WS_WIN) + (size_t)l * DIN * DM, M_PAD, DIN, DM, DM};
            DeferOrder S; S.S.init(ROW_S0, DIN, c.G, (int)blockIdx.x);
            pg8::EpiInProj E{c.ws, l, 0};
            pg8::gemm_phase<pg8::EpiInProj, DeferOrder, true, true>(c.lds, g, S, E); }
        } else if (k == 1) {
            phase_mixer(c, l);
        } else {
            phase_outproj_norm(c, l);
        }
    }
}

#ifndef MK_MULTI
#define MK_MULTI 0
#endif
extern "C" void kernel_launch(void* const* d_in, const int* in_sizes, int n_in, void* d_out, int out_size, void* d_ws, size_t ws_size, hipStream_t stream) {
    static int grid = 0;
    if (grid == 0) {
        if (n_in != 12 || (size_t)out_size != O_END || ws_size < WS_END2) { fprintf(stderr, "kernel_launch: unexpected shapes: n_in %d out %d ws %zu (need out %zu ws %zu)\n", n_in, out_size, ws_size, (size_t)O_END, (size_t)WS_END); grid = -1; return; }
        int dev = 0, cus = 0, per_cu = 0;
        if (hipGetDevice(&dev) != hipSuccess || hipDeviceGetAttribute(&cus, hipDeviceAttributeMultiprocessorCount, dev) != hipSuccess) { grid = -1; return; }
        if (hipFuncSetAttribute((const void*)fwd, hipFuncAttributeMaxDynamicSharedMemorySize, LDS_BYTES) != hipSuccess) { fprintf(stderr, "kernel_launch: hipFuncSetAttribute failed\n"); grid = -1; return; }
        if (hipOccupancyMaxActiveBlocksPerMultiprocessor(&per_cu, (const void*)fwd, NTHR, LDS_BYTES) != hipSuccess || per_cu < 1) { fprintf(stderr, "kernel_launch: occupancy query says %d blocks per CU\n", per_cu); (void)hipGetLastError(); per_cu = 1; }
        grid = cus;
    }
    if (grid < 0) return;
    (void)hipMemsetAsync((char*)d_ws + WS_CTL, 0, CTL_ZERO_BYTES, stream);
    Args a{};
    for (int i = 0; i < 12; ++i) a.in[i] = (const float*)d_in[i];
    a.out = (float*)d_out; a.ws = (unsigned char*)d_ws;
#if MK_MULTI
    for (int ph = 0; ph < N_PHASES; ++ph) {
        a.ph_lo = ph; a.ph_hi = ph + 1;
        hipLaunchKernelGGL(fwd, dim3(grid), dim3(NTHR), LDS_BYTES, stream, a);
    }
#else
    a.ph_lo = 0; a.ph_hi = N_PHASES;
    hipLaunchKernelGGL(fwd, dim3(grid), dim3(NTHR), LDS_BYTES, stream, a);
#endif
}
```

```cpp
#include <hip/hip_runtime.h>
#include <cstdio>
#include <cstdint>
namespace pg8 {
#define PG8_LAS __attribute__((address_space(3)))
typedef unsigned short bf16_t;
typedef short bf16x8 __attribute__((ext_vector_type(8)));
typedef float f32x4 __attribute__((ext_vector_type(4)));
typedef unsigned u32x4 __attribute__((ext_vector_type(4)));
constexpr int BM = 256, BK = 64, HALF = 128, HTB = HALF * BK * 2  , STAGE_BYTES = 8 * HTB, NXCD = 8, WGM = 8;

__host__ __device__ __forceinline__ int lds_byte(int r, int c) { const int st = (r >> 4) * 2 + (c >> 5), rr = r & 15, cc = c & 31, ob = rr * 64 + cc * 2; return st * 1024 + (ob ^ (((ob >> 9) & 1) << 5)); }
__host__ __device__ __forceinline__ void stage_rc(int b, int& R, int& C) { const int st = b / 1024, sb = b % 1024, swz = sb ^ (((sb >> 9) & 1) << 5); R = (st >> 1) * 16 + swz / 64; C = (st & 1) * 32 + (swz % 64) / 2; }
__host__ __device__ __forceinline__ int perm32(int rho) { const int n = rho >> 4, i = rho & 15; return 8 * (i >> 2) + 4 * n + (i & 3); }

struct Unit { int pm, pn; };
struct Gemm { const bf16_t* A; const bf16_t* Bt; int M, N, K, ld; };

struct StaticOrder {
    int nM, nN, nwg, G, c;
    __host__ __device__ void init(int M, int N, int G_, int c_) { nM = M / BM; nN = N / BM; nwg = nM * nN; G = G_; c = c_; }
    __host__ __device__ bool next(int i, Unit& u) const {
        const long L = (long)i * G + c; if (L >= nwg) return false;
        int wgid = (int)L; { const int q = nwg / NXCD, r = nwg % NXCD, xcd = wgid % NXCD, off = wgid / NXCD; wgid = (xcd < r ? xcd * (q + 1) : r * (q + 1) + (xcd - r) * q) + off; }
        const int nig = WGM * nN, gid = wgid / nig, fm = gid * WGM, gsz = (nM - fm) < WGM ? (nM - fm) : WGM;
        u.pm = fm + ((wgid % nig) % gsz); u.pn = (wgid % nig) / gsz; return true;
    }
    __device__ __forceinline__ void a_ready(const Unit&) const {}
    __device__ __forceinline__ void done(const Unit&) const {}
};

__device__ __forceinline__ unsigned cvt_pk_bf16(float lo, float hi) { unsigned r; asm volatile("v_cvt_pk_bf16_f32 %0, %1, %2" : "=v"(r) : "v"(lo), "v"(hi)); return r; }
typedef float f32x2 __attribute__((ext_vector_type(2)));
template <class Epi, class Sched, bool ALIGN_EPI = false, bool SP2 = false>
__device__ __forceinline__ void gemm_phase(PG8_LAS unsigned char* lds, const Gemm g, const Sched& S, const Epi& E) {
    int tid_ = threadIdx.x; asm volatile("" : "+v"(tid_));
    const int tid = tid_, wid = __builtin_amdgcn_readfirstlane(tid >> 6), lane = tid & 63, wr = wid >> 2, wc = wid & 3, fr = lane & 15, fq = lane >> 4;
    const int K = g.ld, nt = g.K / BK;
    unsigned voffA[2], voffB[2];
#pragma unroll
    for (int i = 0; i < 2; ++i) { int R, C; stage_rc(tid * 16 + i * 8192, R, C); const int Rb = Epi::PERM ? ((R & ~31) + perm32(R & 31)) : R;
        voffA[i] = (unsigned)(R * K + C) * 2u; voffB[i] = (unsigned)(Rb * K + C) * 2u; }
    const size_t kstep = (size_t)(BK * 2);
    const size_t hstep = (size_t)HALF * K * 2;
    const size_t tstep = 2 * hstep;
    const unsigned ldsw = (unsigned)wid * 1024u;
    const int aoff = lds_byte(wr * 64 + fr, fq * 8), boff = lds_byte(wc * 32 + fr, fq * 8);
#define PG8_SA(b, h) (((b) * 2 + (h)) * HTB)
#define PG8_SB(b, h) ((4 + (b) * 2 + (h)) * HTB)
#define PG8_STAGE(bufoff, gbase, voff) do { _Pragma("unroll") for (int _i = 0; _i < 2; ++_i) \
        __builtin_amdgcn_global_load_lds((const unsigned*)((const char*)(gbase) + (voff)[_i]), (PG8_LAS unsigned*)(lds + (bufoff) + ldsw + _i * 8192), 16, 0, 0); } while (0)
#define PG8_LDA(dst, b, h) do { _Pragma("unroll") for (int m = 0; m < 4; ++m) _Pragma("unroll") for (int k = 0; k < 2; ++k) dst[m][k] = *(const PG8_LAS bf16x8*)(lds + PG8_SA(b, h) + aoff + m * 2048 + k * 1024); } while (0)
#define PG8_LDB(dst, b, h) do { _Pragma("unroll") for (int n = 0; n < 2; ++n) _Pragma("unroll") for (int k = 0; k < 2; ++k) dst[n][k] = *(const PG8_LAS bf16x8*)(lds + PG8_SB(b, h) + boff + n * 2048 + k * 1024); } while (0)
#define PG8_MMA(ai, bj, At, Bt) do { __builtin_amdgcn_s_setprio(1); _Pragma("unroll") for (int m = 0; m < 4; ++m) _Pragma("unroll") for (int n = 0; n < 2; ++n) _Pragma("unroll") for (int k = 0; k < 2; ++k) \
        acc[ai][bj][m][n] = __builtin_amdgcn_mfma_f32_16x16x32_bf16(Bt[n][k], At[m][k], acc[ai][bj][m][n], 0, 0, 0); __builtin_amdgcn_s_setprio(0); } while (0)
#define PG8_WAIT_V(n) asm volatile("s_waitcnt vmcnt(" #n ")" ::: "memory")
#define PG8_WAIT_L(n) asm volatile("s_waitcnt lgkmcnt(" #n ")" ::: "memory")
#define PG8_BAR __builtin_amdgcn_s_barrier()
#define PG8_SCHED __builtin_amdgcn_sched_barrier(0)
    Unit cur, nxt; int ui = 0;
    if (!S.next(0, cur)) return;
    f32x4 acc[2][2][4][2];
#pragma unroll
    for (int a = 0; a < 2; ++a)
#pragma unroll
        for (int b = 0; b < 2; ++b)
#pragma unroll
            for (int m = 0; m < 4; ++m)
#pragma unroll
                for (int n = 0; n < 2; ++n) acc[a][b][m][n] = (f32x4){0.f, 0.f, 0.f, 0.f};
    bf16x8 At[4][2], B0[2][2], B1[2][2];
    const char* cA = (const char*)g.A + (size_t)cur.pm * tstep; const char* cB = (const char*)g.Bt + (size_t)cur.pn * tstep;
    S.a_ready(cur);
    if constexpr (SP2) {
        PG8_STAGE(PG8_SB(0, 0), cB, voffB); PG8_STAGE(PG8_SB(0, 1), cB + hstep, voffB); PG8_STAGE(PG8_SA(0, 0), cA, voffA); PG8_STAGE(PG8_SA(0, 1), cA + hstep, voffA);
        if (wr == 1) PG8_BAR;
        PG8_WAIT_V(2); PG8_BAR;
        PG8_STAGE(PG8_SB(1, 0), cB + kstep, voffB); PG8_STAGE(PG8_SA(1, 0), cA + kstep, voffA); PG8_STAGE(PG8_SB(1, 1), cB + hstep + kstep, voffB);
        PG8_WAIT_V(6); PG8_BAR;
    } else {
        PG8_STAGE(PG8_SB(0, 0), cB, voffB); PG8_STAGE(PG8_SA(0, 0), cA, voffA); PG8_STAGE(PG8_SB(0, 1), cB + hstep, voffB); PG8_STAGE(PG8_SA(0, 1), cA + hstep, voffA);
        if (wr == 1) PG8_BAR;
        PG8_WAIT_V(4); PG8_BAR;
        PG8_STAGE(PG8_SB(1, 0), cB + kstep, voffB); PG8_STAGE(PG8_SA(1, 0), cA + kstep, voffA); PG8_STAGE(PG8_SB(1, 1), cB + hstep + kstep, voffB);
        PG8_WAIT_V(6); PG8_BAR;
    }
    for (;;) {
        const bool has_next = S.next(ui + 1, nxt);
        const char* nA = has_next ? (const char*)g.A + (size_t)nxt.pm * tstep : cA; const char* nB = has_next ? (const char*)g.Bt + (size_t)nxt.pn * tstep : cB;
        for (int t = 0; t < nt; t += 2) {
            const bool last = (t == nt - 2);
            const char* a1 = cA + (size_t)(t + 1) * kstep;
            const char* a2 = last ? nA : cA + (size_t)(t + 2) * kstep; const char* b2 = last ? nB : cB + (size_t)(t + 2) * kstep;
            const char* a3 = a2 + kstep; const char* b3 = b2 + kstep;
            if (last && has_next) S.a_ready(nxt);
            if constexpr (SP2) {
            PG8_LDB(B0, 0, 0); PG8_LDB(B1, 0, 1); PG8_SCHED; PG8_LDA(At, 0, 0); PG8_STAGE(PG8_SA(1, 1), a1 + hstep, voffA);
            PG8_WAIT_V(8); PG8_WAIT_L(0); PG8_BAR; PG8_MMA(0, 0, At, B0); PG8_MMA(0, 1, At, B1); PG8_BAR; PG8_SCHED;
            PG8_LDA(At, 0, 1); PG8_STAGE(PG8_SB(0, 0), b2, voffB); PG8_STAGE(PG8_SB(0, 1), b2 + hstep, voffB); PG8_STAGE(PG8_SA(0, 0), a2, voffA);
            PG8_WAIT_V(8); PG8_WAIT_L(0); PG8_BAR; PG8_MMA(1, 0, At, B0); PG8_MMA(1, 1, At, B1); PG8_BAR; PG8_SCHED;
            PG8_LDB(B0, 1, 0); PG8_LDB(B1, 1, 1); PG8_SCHED; PG8_LDA(At, 1, 0); PG8_STAGE(PG8_SA(0, 1), a2 + hstep, voffA);
            PG8_WAIT_V(8); PG8_WAIT_L(0); PG8_BAR; PG8_MMA(0, 0, At, B0); PG8_MMA(0, 1, At, B1); PG8_BAR; PG8_SCHED;
            PG8_LDA(At, 1, 1); PG8_STAGE(PG8_SB(1, 0), b3, voffB); PG8_STAGE(PG8_SB(1, 1), b3 + hstep, voffB); PG8_STAGE(PG8_SA(1, 0), a3, voffA);
            PG8_WAIT_V(8); PG8_WAIT_L(0); PG8_BAR; PG8_MMA(1, 0, At, B0); PG8_MMA(1, 1, At, B1); PG8_BAR; PG8_SCHED;
            } else {
            PG8_LDB(B0, 0, 0); PG8_SCHED; PG8_LDA(At, 0, 0); PG8_STAGE(PG8_SA(1, 1), a1 + hstep, voffA);
            PG8_WAIT_L(8); PG8_BAR; PG8_WAIT_L(0); PG8_MMA(0, 0, At, B0); PG8_BAR; PG8_SCHED;
            PG8_LDB(B1, 0, 1); PG8_STAGE(PG8_SB(0, 0), b2, voffB);
            PG8_BAR; PG8_WAIT_L(0); PG8_MMA(0, 1, At, B1); PG8_BAR;
            PG8_LDA(At, 0, 1); PG8_STAGE(PG8_SA(0, 0), a2, voffA);
            PG8_BAR; PG8_WAIT_L(0); PG8_MMA(1, 0, At, B0); PG8_BAR; PG8_SCHED;
            PG8_STAGE(PG8_SB(0, 1), b2 + hstep, voffB);
            PG8_WAIT_V(6); PG8_BAR; PG8_MMA(1, 1, At, B1); PG8_BAR;
            PG8_LDB(B0, 1, 0); PG8_SCHED; PG8_LDA(At, 1, 0); PG8_STAGE(PG8_SA(0, 1), a2 + hstep, voffA);
            PG8_WAIT_L(8); PG8_BAR; PG8_WAIT_L(0); PG8_MMA(0, 0, At, B0); PG8_BAR; PG8_SCHED;
            PG8_LDB(B1, 1, 1); PG8_STAGE(PG8_SB(1, 0), b3, voffB);
            PG8_BAR; PG8_WAIT_L(0); PG8_MMA(0, 1, At, B1); PG8_BAR;
            PG8_LDA(At, 1, 1); PG8_STAGE(PG8_SA(1, 0), a3, voffA);
            PG8_BAR; PG8_WAIT_L(0); PG8_MMA(1, 0, At, B0); PG8_BAR; PG8_SCHED;
            PG8_STAGE(PG8_SB(1, 1), b3 + hstep, voffB);
            PG8_WAIT_V(6); PG8_BAR; PG8_MMA(1, 1, At, B1); PG8_BAR;
            }
        }
        if constexpr (ALIGN_EPI) { if (wr == 0) PG8_BAR; }
        if constexpr (!Epi::AFTER_DRAIN) { E(acc, cur, wr, wc, fr, fq); S.done(cur); }
        if (!has_next) break;
#pragma unroll
        for (int a = 0; a < 2; ++a)
#pragma unroll
            for (int b = 0; b < 2; ++b)
#pragma unroll
                for (int m = 0; m < 4; ++m)
#pragma unroll
                    for (int n = 0; n < 2; ++n) acc[a][b][m][n] = (f32x4){0.f, 0.f, 0.f, 0.f};
        cur = nxt; cA = nA; cB = nB; ++ui;
        if constexpr (ALIGN_EPI) { if (wr == 1) PG8_BAR; }
    }
    PG8_WAIT_V(0);
    if constexpr (!ALIGN_EPI) { if (wr == 0) PG8_BAR; }
    PG8_BAR;
    if constexpr (Epi::AFTER_DRAIN) { E.fused(acc, cur, wr, wc, fr, fq, lds, wid, lane); S.done(cur); }
#undef PG8_SA
#undef PG8_SB
#undef PG8_STAGE
#undef PG8_LDA
#undef PG8_LDB
#undef PG8_MMA
#undef PG8_WAIT_V
#undef PG8_WAIT_L
#undef PG8_BAR
#undef PG8_SCHED
}
}

#define DI __device__ __forceinline__
#define GAS __attribute__((address_space(1)))
#define LAS __attribute__((address_space(3)))
typedef unsigned short bf16;
typedef unsigned v4u __attribute__((ext_vector_type(4)));
typedef unsigned v2u __attribute__((ext_vector_type(2)));
typedef float f32x4 __attribute__((ext_vector_type(4)));
typedef float f32x2 __attribute__((ext_vector_type(2)));

constexpr int NWAVES = 8, NTHR = 512;
constexpr int DM = 2048, DIN = 8192, WA = 1024, NH = 8, HD = 128, DEPTH = 4;
constexpr int BATCH = 4, SEQ = 2048, NMETA = 16, DECB = 128, DECT = 4;
constexpr int ROW_S0 = BATCH * SEQ;
constexpr int ROW_M0 = ROW_S0 + DECB * DECT;
constexpr int M_ROWS = ROW_M0 + BATCH * NMETA;
constexpr int M_PAD = 8960;
constexpr float EPS = 1e-6f;
constexpr int TPB = NMETA + SEQ;

constexpr size_t O_YP = 0, O_YS = O_YP + (size_t)BATCH * SEQ * DM, O_SHP = O_YS + (size_t)DECB * DECT * DM,
                 O_SCP = O_SHP + (size_t)DEPTH * BATCH * NH * HD * HD, O_SHS = O_SCP + (size_t)DEPTH * BATCH * 2 * WA,
                 O_SCS = O_SHS + (size_t)DEPTH * DECB * NH * HD * HD, O_END = O_SCS + (size_t)DEPTH * DECB * 2 * WA;

constexpr size_t MiB = 1u << 20;
constexpr size_t WS_CTL = 0, CTL_ZERO_BYTES = 192 * 1024;
constexpr size_t WS_LB = 1 * MiB, WS_R2 = WS_LB + 64 * 1024, WS_CWT = WS_LB + 128 * 1024;
constexpr size_t WS_WIN = 2 * MiB;
constexpr size_t WS_WOUT = WS_WIN + 128 * MiB;
constexpr size_t WS_H = WS_WOUT + 32 * MiB;
constexpr size_t WS_HN = WS_H + 70 * MiB;
constexpr size_t HALF35 = 35 * MiB / 2;
constexpr size_t WS_Q = WS_HN + 35 * MiB;
constexpr size_t WS_K1 = WS_Q + HALF35, WS_V = WS_K1 + HALF35, WS_ZA = WS_V + HALF35, WS_U = WS_ZA + HALF35, WS_GT = WS_U + HALF35;
constexpr size_t WS_G = WS_GT + HALF35;
constexpr size_t WS_X = WS_G + 35 * MiB;
constexpr size_t WS_MIX = WS_X + 35 * MiB;
constexpr size_t WS_END = WS_MIX + 70 * MiB;
constexpr int XROWS = M_PAD - ROW_S0;
constexpr size_t WS_MIXP = 580 * MiB;
constexpr int CW_BAR = 4096;

constexpr int LDS_BYTES = 163840, MISC_OFF = LDS_BYTES - 128;

#define LDS_WAIT() asm volatile("s_waitcnt lgkmcnt(0)" ::: "memory")
#define VM_WAIT() asm volatile("s_waitcnt vmcnt(0)" ::: "memory")

DI float bf2f(unsigned short b) { return __uint_as_float(((unsigned)b) << 16); }
DI float bflo(unsigned w) { return __uint_as_float(w << 16); }
DI float bfhi(unsigned w) { return __uint_as_float(w & 0xffff0000u); }
DI unsigned pk2(float lo, float hi) { return pg8::cvt_pk_bf16(lo, hi); }
DI unsigned short f2bf1(float f) { return (unsigned short)(pk2(f, 0.f) & 0xffffu); }
DI void unpack8(const v4u w, float* d) { d[0] = bflo(w.x); d[1] = bfhi(w.x); d[2] = bflo(w.y); d[3] = bfhi(w.y); d[4] = bflo(w.z); d[5] = bfhi(w.z); d[6] = bflo(w.w); d[7] = bfhi(w.w); }
DI float row16_sum(float v) {
    v += __builtin_bit_cast(float, __builtin_amdgcn_update_dpp(0, __builtin_bit_cast(int, v), 0xB1, 0xF, 0xF, true));
    v += __builtin_bit_cast(float, __builtin_amdgcn_update_dpp(0, __builtin_bit_cast(int, v), 0x4E, 0xF, 0xF, true));
    v += __builtin_bit_cast(float, __builtin_amdgcn_update_dpp(0, __builtin_bit_cast(int, v), 0x141, 0xF, 0xF, true));
    v += __builtin_bit_cast(float, __builtin_amdgcn_update_dpp(0, __builtin_bit_cast(int, v), 0x140, 0xF, 0xF, true));
    return v;
}
DI float wave_sum(float v) {
    v = row16_sum(v);
    { const auto r = __builtin_amdgcn_permlane16_swap(__float_as_uint(v), __float_as_uint(v), false, false); v = __uint_as_float(r[0]) + __uint_as_float(r[1]); }
    { const auto r = __builtin_amdgcn_permlane32_swap(__float_as_uint(v), __float_as_uint(v), false, false); v = __uint_as_float(r[0]) + __uint_as_float(r[1]); }
    return v;
}
DI float fast_exp(float x) { return __expf(x); }
DI float sigmoidf(float x) { return __builtin_amdgcn_rcpf(1.0f + __expf(-x)); }
DI float siluf(float x) { return x * sigmoidf(x); }

#define XB_TMO      128
#define XB_XCNT(j)  (256  + 64 * (j))
#define XB_XSUB(j)  (1280 + 64 * (j))
#define XB_XGEN(j)  (2304 + 64 * (j))
#define XB_TOP      3328
#define XB_TOPGEN   3392
#define XCD_BAR_WORDS 3456
#define XB_SPIN_CAP (1u << 18)
DI unsigned xb_ld(unsigned* p)              { return __hip_atomic_load(p, __ATOMIC_RELAXED, __HIP_MEMORY_SCOPE_AGENT); }
DI unsigned xb_add(unsigned* p, unsigned v) { return __hip_atomic_fetch_add(p, v, __ATOMIC_RELAXED, __HIP_MEMORY_SCOPE_AGENT); }
DI unsigned xb_xcc_id() { return (unsigned)__builtin_amdgcn_s_getreg((3 << 11) | 20) & 0xFu; }
#define XB_SPIN(cond, bar) do { unsigned _sp = 0; while (cond) { __builtin_amdgcn_s_sleep(1); \
    if ((++_sp & 255u) == 0u) { if (xb_ld(&(bar)[XB_TMO])) break; if (_sp > XB_SPIN_CAP) { atomicAdd(&(bar)[XB_TMO], 1u); break; } } } } while (0)
struct XcdBarrier { unsigned* bar; unsigned x; volatile LAS unsigned* st; };
DI XcdBarrier xcd_barrier_post(unsigned* bar, volatile LAS unsigned* st) {
    XcdBarrier b; b.bar = bar; b.x = xb_xcc_id(); b.st = st;
    if (threadIdx.x == 0) (void)xb_add(&bar[XB_XCNT(b.x)], 1u);
    return b;
}
DI void xcd_barrier_complete(unsigned* bar, unsigned x, unsigned& nloc, unsigned& nx) {
    const unsigned G = gridDim.x * gridDim.y * gridDim.z;
    unsigned sum, cnt, mine, sp = 0u;
    for (;;) {
        sum = 0u; cnt = 0u; mine = 0u;
#pragma unroll
        for (unsigned j = 0; j < 16; ++j) { const unsigned c = xb_ld(&bar[XB_XCNT(j)]); sum += c; cnt += (c > 0u) ? 1u : 0u; mine = (j == x) ? c : mine; }
        if (sum == G) break;
        __builtin_amdgcn_s_sleep(1);
        if ((++sp & 255u) == 0u) { if (xb_ld(&bar[XB_TMO])) break; if (sp > XB_SPIN_CAP) { atomicAdd(&bar[XB_TMO], 1u); break; } }
    }
    nloc = mine > 0u ? mine : 1u; nx = cnt > 0u ? cnt : 1u;
}
DI void xcd_barrier(const XcdBarrier& b) {
    asm volatile("s_waitcnt vmcnt(0)" ::: "memory");
    __syncthreads();
    if (threadIdx.x == 0) {
        unsigned* bar = b.bar;
        __builtin_amdgcn_s_waitcnt(0);
        unsigned nloc = b.st[0], nx = b.st[1];
        if (nloc == 0u) { xcd_barrier_complete(bar, b.x, nloc, nx); b.st[0] = nloc; b.st[1] = nx; }
        const unsigned old = xb_add(&bar[XB_XSUB(b.x)], 1u);
        const unsigned gen = old / nloc;
        if (old + 1u == (gen + 1u) * nloc) {
            __builtin_amdgcn_fence(__ATOMIC_RELEASE, "agent");
            asm volatile("s_waitcnt vmcnt(0)" ::: "memory");
            const unsigned og = xb_add(&bar[XB_TOP], 1u);
            const unsigned tg = og / nx;
            if (og + 1u == (tg + 1u) * nx) xb_add(&bar[XB_TOPGEN], 1u);
            else XB_SPIN(xb_ld(&bar[XB_TOPGEN]) == tg, bar);
            __builtin_amdgcn_fence(__ATOMIC_ACQUIRE, "agent");
            xb_add(&bar[XB_XGEN(b.x)], 1u);
            asm volatile("s_waitcnt vmcnt(0)" ::: "memory");
        } else {
            XB_SPIN(xb_ld(&bar[XB_XGEN(b.x)]) == gen, bar);
            __builtin_amdgcn_fence(__ATOMIC_ACQUIRE, "agent");
            asm volatile("s_waitcnt vmcnt(0)" ::: "memory");
        }
    }
    __syncthreads();
}

struct Ctx {
    LAS unsigned char* lds;
    int vcu, G;
    const float *x_prompt, *x_sample, *state_hgrn, *state_conv, *meta, *w_in, *conv_w, *lb_param, *hgrn_nw, *w_out, *pre_w, *post_w;
    float* out;
    unsigned char* ws;
};
struct Tid { int tid, lane, wave; };
DI Tid get_tid() {
    int t = threadIdx.x; asm volatile("" : "+v"(t));
    Tid r; r.tid = t; r.lane = t & 63; r.wave = __builtin_amdgcn_readfirstlane(t >> 6); return r;
}
DI const float* in_row(const Ctx& c, int row) {
    if (row < ROW_S0) return c.x_prompt + (size_t)row * DM;
    if (row < ROW_M0) return c.x_sample + (size_t)(row - ROW_S0) * DM;
    return c.meta + (size_t)((row - ROW_M0) & (NMETA - 1)) * DM;
}
DI int prompt_row(int b, int p) { return p < NMETA ? ROW_M0 + b * NMETA + p : b * SEQ + (p - NMETA); }

DI int src_col_in(int np) {
    if (np < 4096) return np;
    const int pn = np >> 8, p = np & 255;
    const int s = 2 * (p >> 7) + ((p >> 2) & 1), wc = (p >> 5) & 3, fq = (p >> 3) & 3, j = p & 3;
    return 4096 + s * 1024 + (pn - 16) * 64 + 16 * wc + 4 * fq + j;
}

DI void transpose_item(const float* W, int K, int N, bf16* WT, LAS float* scr, int item, int lane, bool perm, const float* kscale) {
    const int nblk = N / 64, kb = item / nblk, nb = item - kb * nblk, k0 = 64 * kb, n0 = 64 * nb;
    const int np4 = n0 + 4 * (lane & 15);
    const int sc = perm ? src_col_in(np4) : np4;
    f32x4 v[16];
#pragma unroll
    for (int i = 0; i < 16; ++i) v[i] = __builtin_nontemporal_load((const f32x4*)(W + (size_t)(k0 + 4 * i + (lane >> 4)) * N + sc));
#pragma unroll
    for (int i = 0; i < 16; ++i) { const int kk = 4 * i + (lane >> 4); const float ks = kscale ? kscale[k0 + kk] : 1.0f; LAS float* d = scr + kk * 65 + 4 * (lane & 15);
        d[0] = v[i].x * ks; d[1] = v[i].y * ks; d[2] = v[i].z * ks; d[3] = v[i].w * ks; }
    LDS_WAIT();
    const int c8 = lane & 7;
#pragma unroll
    for (int j = 0; j < 8; ++j) { const int n = (lane >> 3) + 8 * j; const LAS float* s = scr + (8 * c8) * 65 + n;
        v4u o; o.x = pk2(s[0 * 65], s[1 * 65]); o.y = pk2(s[2 * 65], s[3 * 65]); o.z = pk2(s[4 * 65], s[5 * 65]); o.w = pk2(s[6 * 65], s[7 * 65]);
        *(v4u*)(WT + (size_t)(n0 + n) * K + k0 + 8 * c8) = o; }
    LDS_WAIT();
}
constexpr int PREP_I_IN = (DM / 64) * (DIN / 64), PREP_I_OUT = (DM / 64) * (DM / 64), PREP_ITEMS = PREP_I_IN + PREP_I_OUT;
DI void prep_layer(const Ctx& c, int l, int it_lo, int it_hi, int it_step) {
    const Tid t_ = get_tid(); const int lane = t_.lane, wave = t_.wave;
    LAS float* scr = (LAS float*)(c.lds + wave * 16640);
    for (int it = it_lo + wave; it < it_hi; it += it_step) {
        if (it < PREP_I_IN) transpose_item(c.w_in + (size_t)l * DM * DIN, DM, DIN, (bf16*)(c.ws + WS_WIN) + (size_t)l * DIN * DM, scr, it, lane, true, c.pre_w + (size_t)l * DM);
        else transpose_item(c.w_out + (size_t)l * DM * DM, DM, DM, (bf16*)(c.ws + WS_WOUT) + (size_t)l * DM * DM, scr, it - PREP_I_IN, lane, false, nullptr);
    }
}
DI void phase_prep(const Ctx& c) {
    const Tid t_ = get_tid(); const int tid = t_.tid;
    prep_layer(c, 0, c.vcu * NWAVES, PREP_I_IN, c.G * NWAVES);
    for (int i = c.vcu * NTHR + tid; i < DEPTH * 3 * WA; i += c.G * NTHR) ((float*)(c.ws + WS_CWT))[i] = c.conv_w[i];
    const int gt = c.vcu * NTHR + tid;
    if (gt < WA) {
        float p[DEPTH], mx = -3.0e38f;
#pragma unroll
        for (int l = 0; l < DEPTH; ++l) { p[l] = c.lb_param[l * WA + gt]; mx = fmaxf(mx, p[l]); }
        float s = 0.f;
#pragma unroll
        for (int l = 0; l < DEPTH; ++l) { p[l] = expf(p[l] - mx); s += p[l]; }
        float* LB = (float*)(c.ws + WS_LB); float cum = 0.f;
#pragma unroll
        for (int l = 0; l < DEPTH; ++l) { if (l > 0) cum += p[l] / s; LB[l * WA + gt] = cum; }
    }
}

struct NormRow { f32x4 hf[8]; v4u hb[4]; v4u mx[4]; };
DI void norm_row_load(const Ctx& c, int l, int row, int lane, NormRow& R) {
    const bf16* Hb = (const bf16*)(c.ws + WS_HN); const bf16* MIX = (const bf16*)(c.ws + WS_MIX);
    if (l == 0) { const float* src = in_row(c, row);
#pragma unroll
        for (int j = 0; j < 4; ++j) { R.hf[2 * j] = *(const f32x4*)(src + 8 * (lane + 64 * j)); R.hf[2 * j + 1] = *(const f32x4*)(src + 8 * (lane + 64 * j) + 4); } }
    else {
#pragma unroll
        for (int j = 0; j < 4; ++j) R.hb[j] = __builtin_nontemporal_load((const v4u*)(Hb + (size_t)row * DM + 8 * (lane + 64 * j))); }
    if (l >= 1 && row < ROW_S0) {
#pragma unroll
        for (int j = 0; j < 4; ++j) R.mx[j] = __builtin_nontemporal_load((const v4u*)(MIX + (size_t)row * DM + 8 * (lane + 64 * j))); }
}
DI void norm_row_finish(const Ctx& c, int l, int row, int lane, const NormRow& R, bool dry) {
    bf16* Hb = (bf16*)(c.ws + WS_HN); float* R2 = (float*)(c.ws + WS_R2);
    float h[32];
    if (l == 0) {
#pragma unroll
        for (int j = 0; j < 8; ++j) { h[4 * j] = R.hf[j].x; h[4 * j + 1] = R.hf[j].y; h[4 * j + 2] = R.hf[j].z; h[4 * j + 3] = R.hf[j].w; } }
    else {
#pragma unroll
        for (int j = 0; j < 4; ++j) unpack8(R.hb[j], h + 8 * j); }
    if (l >= 1) {
        float m[32]; float ss = 0.f;
        if (row < ROW_S0) {
#pragma unroll
            for (int j = 0; j < 4; ++j) unpack8(R.mx[j], m + 8 * j); }
        else {
            const bf16* MP = (const bf16*)(c.ws + WS_MIXP) + (size_t)(row - ROW_S0) * DM;
#pragma unroll
            for (int e = 0; e < 32; ++e) m[e] = 0.f;
#pragma unroll
            for (int q = 0; q < 4; ++q)
#pragma unroll
                for (int j = 0; j < 4; ++j) { float t8[8]; unpack8(*(const v4u*)(MP + (size_t)q * XROWS * DM + 8 * (lane + 64 * j)), t8);
#pragma unroll
                    for (int e = 0; e < 8; ++e) m[8 * j + e] += t8[e]; } }
#pragma unroll
        for (int e = 0; e < 32; ++e) ss += m[e] * m[e];
        const float r1 = __builtin_amdgcn_rsqf(wave_sum(ss) * (1.0f / DM) + EPS);
        const float* wp = c.post_w + (size_t)(l - 1) * DM;
#pragma unroll
        for (int j = 0; j < 4; ++j) { const f32x4 a = *(const f32x4*)(wp + 8 * (lane + 64 * j)), b2 = *(const f32x4*)(wp + 8 * (lane + 64 * j) + 4);
            h[8 * j] += m[8 * j] * r1 * a.x; h[8 * j + 1] += m[8 * j + 1] * r1 * a.y; h[8 * j + 2] += m[8 * j + 2] * r1 * a.z; h[8 * j + 3] += m[8 * j + 3] * r1 * a.w;
            h[8 * j + 4] += m[8 * j + 4] * r1 * b2.x; h[8 * j + 5] += m[8 * j + 5] * r1 * b2.y; h[8 * j + 6] += m[8 * j + 6] * r1 * b2.z; h[8 * j + 7] += m[8 * j + 7] * r1 * b2.w; }
    }
    if (l < DEPTH) {
        float ss = 0.f;
#pragma unroll
        for (int e = 0; e < 32; ++e) ss += h[e] * h[e];
        const float r2 = __builtin_amdgcn_rsqf(wave_sum(ss) * (1.0f / DM) + EPS);
        if (!dry) {
#pragma unroll
            for (int j = 0; j < 4; ++j) { v4u o; o.x = pk2(h[8 * j], h[8 * j + 1]); o.y = pk2(h[8 * j + 2], h[8 * j + 3]); o.z = pk2(h[8 * j + 4], h[8 * j + 5]); o.w = pk2(h[8 * j + 6], h[8 * j + 7]);
                *(v4u*)(Hb + (size_t)row * DM + 8 * (lane + 64 * j)) = o; }
            if (lane == 0) R2[row] = r2; }
    } else {
        float* dst = row < ROW_S0 ? c.out + O_YP + (size_t)row * DM : (row < ROW_M0 ? c.out + O_YS + (size_t)(row - ROW_S0) * DM : nullptr);
        if (dst) {
#pragma unroll
            for (int j = 0; j < 4; ++j) { __builtin_nontemporal_store((f32x4){h[8 * j], h[8 * j + 1], h[8 * j + 2], h[8 * j + 3]}, (f32x4*)(dst + 8 * (lane + 64 * j)));
                __builtin_nontemporal_store((f32x4){h[8 * j + 4], h[8 * j + 5], h[8 * j + 6], h[8 * j + 7]}, (f32x4*)(dst + 8 * (lane + 64 * j) + 4)); } }
    }
}
DI void norm_rows(const Ctx& c, int l, int row_lo, int row_hi, int row_step, bool dry = false) {
    const Tid t_ = get_tid(); const int lane = t_.lane, wave = t_.wave;
    if (l == 0) {
        for (int row = row_lo + wave; row < row_hi; row += row_step) { NormRow A; norm_row_load(c, l, row, lane, A); norm_row_finish(c, l, row, lane, A, dry); }
        return; }
    for (int row = row_lo + wave; row < row_hi; row += 2 * row_step) {
        const int rowb = row + row_step;
        NormRow A, B;
        norm_row_load(c, l, row, lane, A);
        if (rowb < row_hi) norm_row_load(c, l, rowb, lane, B);
        norm_row_finish(c, l, row, lane, A, dry);
        if (rowb < row_hi) norm_row_finish(c, l, rowb, lane, B, dry);
    }
}
DI void phase_norm(const Ctx& c, int l) { norm_rows(c, l, c.vcu * NWAVES, M_ROWS, c.G * NWAVES); }

namespace pg8 {
struct EpiInProj {
    static constexpr bool PERM = true, AFTER_DRAIN = false;
    unsigned char* ws; int l, pad_;
    __device__ __forceinline__ void operator()(const f32x4 (&acc_in)[2][2][4][2], const Unit& u, int wr, int wc, int fr, int fq) const {
        const int row0 = u.pm * BM + wr * 64 + fr, pn = u.pn;
        f32x4 acc[2][2][4][2];
        { const float* R2 = (const float*)(ws + WS_R2);
#pragma unroll
          for (int ai = 0; ai < 2; ++ai)
#pragma unroll
              for (int m = 0; m < 4; ++m) { const float r2 = R2[row0 + ai * HALF + m * 16];
#pragma unroll
                  for (int bj = 0; bj < 2; ++bj)
#pragma unroll
                      for (int n = 0; n < 2; ++n) acc[ai][bj][m][n] = acc_in[ai][bj][m][n] * r2; } }
        float* const G = (float*)(ws + WS_G); bf16_t* const K1 = (bf16_t*)(ws + WS_K1); bf16_t* const U = (bf16_t*)(ws + WS_U); bf16_t* const GT = (bf16_t*)(ws + WS_GT);
        const float* const lb = (const float*)(ws + WS_LB) + l * 1024;
        if (pn < 16) {
            const int seg = pn >> 2, col0 = (pn & 3) * 256 + wc * 32 + 8 * fq;
            if (seg == 1) {
                f32x4 lbv[2][2];
#pragma unroll
                for (int bj = 0; bj < 2; ++bj)
#pragma unroll
                    for (int n = 0; n < 2; ++n) lbv[bj][n] = *(const f32x4*)(lb + col0 + bj * HALF + 4 * n);
#pragma unroll
                for (int ai = 0; ai < 2; ++ai)
#pragma unroll
                    for (int m = 0; m < 4; ++m) { const size_t ro = (size_t)(row0 + ai * HALF + m * 16) * 1024 + col0;
#pragma unroll
                        for (int bj = 0; bj < 2; ++bj) { f32x4 gk[2], kk[2];
#pragma unroll
                            for (int n = 0; n < 2; ++n)
#pragma unroll
                                for (int e = 0; e < 4; ++e) { const float z = acc[ai][bj][m][n][e], lbe = lbv[bj][n][e];
                                    const float ez = __expf(-fabsf(z)), sp = __builtin_amdgcn_rcpf(1.0f + ez), sn = ez * sp;
                                    const float sg = z >= 0.f ? sp : sn, sm = z >= 0.f ? sn : sp;
                                    const float f = lbe + (1.0f - lbe) * sg;
                                    gk[n][e] = __logf(fmaxf(f, 1e-30f)); kk[n][e] = (1.0f - lbe) * sm; }
                            *(f32x4*)(G + ro + bj * HALF) = gk[0]; *(f32x4*)(G + ro + bj * HALF + 4) = gk[1];
                            u32x4 w; w.x = cvt_pk_bf16(kk[0][0], kk[0][1]); w.y = cvt_pk_bf16(kk[0][2], kk[0][3]); w.z = cvt_pk_bf16(kk[1][0], kk[1][1]); w.w = cvt_pk_bf16(kk[1][2], kk[1][3]);
                            *(u32x4*)(K1 + ro + bj * HALF) = w; } }
            } else {
                bf16_t* base = (bf16_t*)(ws + (seg == 0 ? WS_Q : (seg == 2 ? WS_V : WS_ZA)));
#pragma unroll
                for (int ai = 0; ai < 2; ++ai)
#pragma unroll
                    for (int m = 0; m < 4; ++m) { const size_t ro = (size_t)(row0 + ai * HALF + m * 16) * 1024 + col0;
#pragma unroll
                        for (int bj = 0; bj < 2; ++bj) { f32x4 v0 = acc[ai][bj][m][0], v1 = acc[ai][bj][m][1];
                            if (seg == 3) {
#pragma unroll
                                for (int e = 0; e < 4; ++e) { v0[e] = v0[e] * __builtin_amdgcn_rcpf(1.0f + __expf(-v0[e])); v1[e] = v1[e] * __builtin_amdgcn_rcpf(1.0f + __expf(-v1[e])); } }
                            u32x4 w; w.x = cvt_pk_bf16(v0[0], v0[1]); w.y = cvt_pk_bf16(v0[2], v0[3]); w.z = cvt_pk_bf16(v1[0], v1[1]); w.w = cvt_pk_bf16(v1[2], v1[3]);
                            *(u32x4*)(base + ro + bj * HALF) = w; } }
            }
        } else {
            const int ch0 = (pn - 16) * 64 + wc * 16 + fq * 4;
            typedef unsigned u32x2 __attribute__((ext_vector_type(2)));
            if (u.pm < ROW_S0 / BM) {
                const float* cwt = (const float*)(ws + WS_CWT) + (size_t)l * 3 * 1024 + ch0;
                const f32x4 w0 = *(const f32x4*)cwt, w1 = *(const f32x4*)(cwt + 1024), w2 = *(const f32x4*)(cwt + 2048);
                bf16_t* const X = (bf16_t*)(ws + WS_X);
#pragma unroll
                for (int ai = 0; ai < 2; ++ai) { f32x4 p1 = {0.f, 0.f, 0.f, 0.f}, p2 = p1;
#pragma unroll
                    for (int m = 0; m < 4; ++m) { const size_t row = (size_t)(row0 + ai * HALF + m * 16), ro = row * 1024 + ch0;
                        const f32x4 bg = acc[ai][0][m][0], cg = acc[ai][0][m][1], xt = acc[ai][1][m][0], zb = acc[ai][1][m][1];
                        f32x4 uu = cg * xt, gt, t1, t2;
#pragma unroll
                        for (int e = 0; e < 4; ++e) { gt[e] = bg[e] * zb[e] * __builtin_amdgcn_rcpf(1.0f + __expf(-zb[e]));
                            float r1_, r2_; const float ue_ = uu[e];
                            asm volatile("s_nop 1\n\tv_mov_b32_dpp %0, %2 row_ror:1 row_mask:0xf bank_mask:0xf bound_ctrl:1\n\tv_mov_b32_dpp %1, %2 row_ror:2 row_mask:0xf bank_mask:0xf bound_ctrl:1" : "=&v"(r1_), "=&v"(r2_) : "v"(ue_));
                            t1[e] = r1_; t2[e] = r2_; }
                        const f32x4 q1 = fr >= 1 ? t1 : p1, q2 = fr >= 2 ? t2 : p2;
                        const f32x4 y = gt * (w0 * q2 + w1 * q1 + w2 * uu);
                        u32x2 yo; yo.x = cvt_pk_bf16(y[0], y[1]); yo.y = cvt_pk_bf16(y[2], y[3]);
                        *(u32x2*)(X + row * 2048 + 1024 + ch0) = yo;
                        if ((m == 0 && fr < 2) || (m == 3 && fr >= 14)) { u32x2 a; a.x = cvt_pk_bf16(uu[0], uu[1]); a.y = cvt_pk_bf16(uu[2], uu[3]); *(u32x2*)(U + ro) = a; }
                        if (m == 0 && fr < 2) { u32x2 b; b.x = cvt_pk_bf16(gt[0], gt[1]); b.y = cvt_pk_bf16(gt[2], gt[3]); *(u32x2*)(GT + ro) = b; }
                        p1 = t1; p2 = t2; } }
            } else
#pragma unroll
            for (int ai = 0; ai < 2; ++ai)
#pragma unroll
                for (int m = 0; m < 4; ++m) { const size_t ro = (size_t)(row0 + ai * HALF + m * 16) * 1024 + ch0;
                    const f32x4 bg = acc[ai][0][m][0], cg = acc[ai][0][m][1], xt = acc[ai][1][m][0], zb = acc[ai][1][m][1];
                    f32x4 uu = cg * xt, gt;
#pragma unroll
                    for (int e = 0; e < 4; ++e) gt[e] = bg[e] * zb[e] * __builtin_amdgcn_rcpf(1.0f + __expf(-zb[e]));
                    u32x2 a, b; a.x = cvt_pk_bf16(uu[0], uu[1]); a.y = cvt_pk_bf16(uu[2], uu[3]); b.x = cvt_pk_bf16(gt[0], gt[1]); b.y = cvt_pk_bf16(gt[2], gt[3]);
                    *(u32x2*)(U + ro) = a; *(u32x2*)(GT + ro) = b; }
        }
    }
};
struct EpiMix {
    static constexpr bool PERM = true, AFTER_DRAIN = false;
    bf16_t* C;
    __device__ __forceinline__ void operator()(const f32x4 (&acc)[2][2][4][2], const Unit& u, int wr, int wc, int fr, int fq) const {
        const int row0 = u.pm * BM + wr * 64 + fr, col0 = u.pn * BM + wc * 32 + 8 * fq;
        const __amdgpu_buffer_rsrc_t rs = __builtin_amdgcn_make_buffer_rsrc((void*)C, (short)0, (int)(35u << 20), 0x00020000);
#pragma unroll
        for (int ai = 0; ai < 2; ++ai)
#pragma unroll
            for (int m = 0; m < 4; ++m) { const unsigned ro = (unsigned)(((row0 + ai * HALF + m * 16) * 2048 + col0) * 2);
#pragma unroll
                for (int bj = 0; bj < 2; ++bj) { const f32x4 v0 = acc[ai][bj][m][0], v1 = acc[ai][bj][m][1];
                    u32x4 w; w.x = cvt_pk_bf16(v0[0], v0[1]); w.y = cvt_pk_bf16(v0[2], v0[3]); w.z = cvt_pk_bf16(v1[0], v1[1]); w.w = cvt_pk_bf16(v1[2], v1[3]);
                    __builtin_amdgcn_raw_buffer_store_b128(w, rs, (int)(ro + bj * HALF * 2), 0, 16); } }
    }
};
}

DI void phase_conv(const Ctx& c, int l, int wi, int nw_) {
    const bf16* U = (const bf16*)(c.ws + WS_U); const bf16* GT = (const bf16*)(c.ws + WS_GT); bf16* X = (bf16*)(c.ws + WS_X);
    const Tid t_ = get_tid(); const int tid = t_.tid;
    const int sub = tid >> 7, ch0 = (tid & 127) * 8;
    const float* cw = c.conv_w + (size_t)l * 3 * WA + ch0;
    float w0[8], w1[8], w2[8];
#pragma unroll
    for (int e = 0; e < 8; ++e) { w0[e] = cw[e]; w1[e] = cw[WA + e]; w2[e] = cw[2 * WA + e]; }
    const bool blk32 = nw_ == 0;
    const int row_lo = blk32 ? wi * 32 + sub : wi * 4 + sub, row_hi = blk32 ? (wi * 32 + 32 < M_ROWS ? wi * 32 + 32 : M_ROWS) : M_ROWS, row_st = blk32 ? 4 : nw_ * 4;
    const int n_it = nw_ == -1 ? 4 : (row_hi - row_lo + row_st - 1) / row_st;
    for (int it = 0; it < n_it; ++it) {
        const int row = nw_ == -1 ? 64 * (wi * 8 + it * 2 + (sub >> 1)) + (sub & 1) : row_lo + it * row_st;
        int r1, r2, db = 0;
        if (row < ROW_S0) { const int b = row >> 11, t = row & (SEQ - 1);
            r1 = t >= 1 ? row - 1 : ROW_M0 + b * NMETA + 15;
            r2 = t >= 2 ? row - 2 : ROW_M0 + b * NMETA + 14 + t; }
        else if (row < ROW_M0) { const int idx = row - ROW_S0, j = idx & 3; db = idx >> 2;
            r1 = j >= 1 ? row - 1 : -2;
            r2 = j >= 2 ? row - 2 : (j == 1 ? -2 : -3); }
        else { const int m = (row - ROW_M0) & 15;
            r1 = m >= 1 ? row - 1 : -1;
            r2 = m >= 2 ? row - 2 : -1; }
        float u0[8], u1[8], u2[8];
        { const v4u w = *(const v4u*)(U + (size_t)row * WA + ch0);
          u0[0] = bflo(w.x); u0[1] = bfhi(w.x); u0[2] = bflo(w.y); u0[3] = bfhi(w.y); u0[4] = bflo(w.z); u0[5] = bfhi(w.z); u0[6] = bflo(w.w); u0[7] = bfhi(w.w); }
#pragma unroll
        for (int which = 0; which < 2; ++which) {
            const int r = which == 0 ? r1 : r2; float* d = which == 0 ? u1 : u2;
            if (r >= 0) { const v4u w = *(const v4u*)(U + (size_t)r * WA + ch0);
                d[0] = bflo(w.x); d[1] = bfhi(w.x); d[2] = bflo(w.y); d[3] = bfhi(w.y); d[4] = bflo(w.z); d[5] = bfhi(w.z); d[6] = bflo(w.w); d[7] = bfhi(w.w); }
            else if (r == -1) {
#pragma unroll
                for (int e = 0; e < 8; ++e) d[e] = 0.f; }
            else { const float* sc = c.state_conv + (((size_t)l * DECB + db) * 2 + (r == -2 ? 1 : 0)) * WA + ch0;
#pragma unroll
                for (int e = 0; e < 8; ++e) d[e] = sc[e]; }
        }
        const v4u gw = *(const v4u*)(GT + (size_t)row * WA + ch0);
        float g[8] = {bflo(gw.x), bfhi(gw.x), bflo(gw.y), bfhi(gw.y), bflo(gw.z), bfhi(gw.z), bflo(gw.w), bfhi(gw.w)};
        float y[8];
#pragma unroll
        for (int e = 0; e < 8; ++e) y[e] = g[e] * (w0[e] * u2[e] + w1[e] * u1[e] + w2[e] * u0[e]);
        v4u o; o.x = pk2(y[0], y[1]); o.y = pk2(y[2], y[3]); o.z = pk2(y[4], y[5]); o.w = pk2(y[6], y[7]);
        *(v4u*)(X + (size_t)row * DM + WA + ch0) = o;
        float* so = nullptr;
        if (row < ROW_S0) { const int b = row >> 11, t = row & (SEQ - 1); if (t >= SEQ - 2) so = c.out + O_SCP + (((size_t)l * BATCH + b) * 2 + (t - (SEQ - 2))) * WA + ch0; }
        else if (row < ROW_M0) { const int idx = row - ROW_S0, j = idx & 3; if (j >= 2) so = c.out + O_SCS + (((size_t)l * DECB + (idx >> 2)) * 2 + (j - 2)) * WA + ch0; }
        if (so) { *(f32x4*)so = (f32x4){u0[0], u0[1], u0[2], u0[3]}; *(f32x4*)(so + 4) = (f32x4){u0[4], u0[5], u0[6], u0[7]}; }
    }
    if (nw_ == -1 && wi == 0) {
#pragma unroll
        for (int i = 0; i < 2; ++i) { const int q = sub + 4 * i, b = q >> 1, j = q & 1, row = b * SEQ + SEQ - 2 + j;
            float u0[8]; unpack8(*(const v4u*)(U + (size_t)row * WA + ch0), u0);
            float* so = c.out + O_SCP + (((size_t)l * BATCH + b) * 2 + j) * WA + ch0;
            *(f32x4*)so = (f32x4){u0[0], u0[1], u0[2], u0[3]}; *(f32x4*)(so + 4) = (f32x4){u0[4], u0[5], u0[6], u0[7]}; } }
}

DI void hgrn_sample_item(const Ctx& c, int l, int item) {
    const int db = item >> 3, h = item & 7, hc = h * HD; const Tid t_ = get_tid(); const int tid = t_.tid, lane = t_.lane, wave = t_.wave;
    LAS float* sQ = (LAS float*)c.lds;
    LAS float* sG = sQ + 512; LAS float* sK = sG + 512; LAS float* sV = sK + 512; LAS float* sZ = sV + 512;
    LAS float* sQE = sZ + 512; LAS float* sKH = sQE + 512; LAS float* sD = sKH + 512;
    LAS float* sA = sD + 128;
    LAS float* sSS = sA + 16;
    LAS float* sRed = sSS + 16;
    const bf16* Q = (const bf16*)(c.ws + WS_Q); const bf16* K1 = (const bf16*)(c.ws + WS_K1); const bf16* V = (const bf16*)(c.ws + WS_V); const bf16* ZA = (const bf16*)(c.ws + WS_ZA);
    const float* G = (const float*)(c.ws + WS_G); bf16* X = (bf16*)(c.ws + WS_X);
    const int row0 = ROW_S0 + db * DECT;
    { const int j = tid >> 7, cc = tid & 127; const size_t o = (size_t)(row0 + j) * WA + hc + cc;
      sQ[tid] = bf2f(Q[o]); sG[tid] = G[o]; sK[tid] = bf2f(K1[o]); sV[tid] = bf2f(V[o]); sZ[tid] = bf2f(ZA[o]); }
    const int kr = tid >> 5, v4 = tid & 31;
    const float* S0 = c.state_hgrn + (((size_t)l * DECB + db) * NH + h) * (size_t)(HD * HD);
    float* S1 = c.out + O_SHS + (((size_t)l * DECB + db) * NH + h) * (size_t)(HD * HD);
    f32x4 s[8];
#pragma unroll
    for (int i = 0; i < 8; ++i) s[i] = __builtin_nontemporal_load((const f32x4*)(S0 + (size_t)(kr + 16 * i) * HD + 4 * v4));
    __syncthreads();
    if (tid < 128) {
        const float g0 = sG[tid], g1 = g0 + sG[128 + tid], g2 = g1 + sG[256 + tid], g3 = g2 + sG[384 + tid];
        sG[tid] = g0; sG[128 + tid] = g1; sG[256 + tid] = g2; sG[384 + tid] = g3;
        sQE[tid] = sQ[tid] * __expf(g0); sQE[128 + tid] = sQ[128 + tid] * __expf(g1); sQE[256 + tid] = sQ[256 + tid] * __expf(g2); sQE[384 + tid] = sQ[384 + tid] * __expf(g3);
        sKH[tid] = sK[tid] * __expf(g3 - g0); sKH[128 + tid] = sK[128 + tid] * __expf(g3 - g1); sKH[256 + tid] = sK[256 + tid] * __expf(g3 - g2); sKH[384 + tid] = sK[384 + tid];
        sD[tid] = __expf(g3);
    }
    __syncthreads();
    for (int p = wave; p < 10; p += NWAVES) {
        int t = 0, s2 = p; if (p >= 6) { t = 3; s2 = p - 6; } else if (p >= 3) { t = 2; s2 = p - 3; } else if (p >= 1) { t = 1; s2 = p - 1; }
        float a = 0.f;
#pragma unroll
        for (int q = 0; q < 2; ++q) { const int k = lane + 64 * q; a += sQ[t * 128 + k] * sK[s2 * 128 + k] * __expf(sG[t * 128 + k] - sG[s2 * 128 + k]); }
        a = wave_sum(a);
        if (lane == 0) sA[t * 4 + s2] = a;
    }
    f32x4 op[4];
#pragma unroll
    for (int t = 0; t < 4; ++t) op[t] = (f32x4){0.f, 0.f, 0.f, 0.f};
    f32x4 vv[4];
#pragma unroll
    for (int t = 0; t < 4; ++t) vv[t] = *(const LAS f32x4*)(sV + t * 128 + 4 * v4);
#pragma unroll
    for (int i = 0; i < 8; ++i) { const int k = kr + 16 * i;
        const f32x4 s0 = s[i];
#pragma unroll
        for (int t = 0; t < 4; ++t) op[t] = op[t] + s0 * sQE[t * 128 + k];
        f32x4 sn = s0 * sD[k];
#pragma unroll
        for (int t = 0; t < 4; ++t) sn = sn + vv[t] * sKH[t * 128 + k];
        __builtin_nontemporal_store(sn, (f32x4*)(S1 + (size_t)k * HD + 4 * v4)); }
#pragma unroll
    for (int t = 0; t < 4; ++t) {
#pragma unroll
        for (int e = 0; e < 4; ++e) op[t][e] += __shfl_xor(op[t][e], 32);
        if (lane < 32) *(LAS f32x4*)(sRed + (wave * 4 + t) * 128 + 4 * v4) = op[t]; }
    __syncthreads();
    { const int t = tid >> 7, v = tid & 127; float o = 0.f;
#pragma unroll
      for (int w = 0; w < NWAVES; ++w) o += sRed[(w * 4 + t) * 128 + v];
      for (int s2 = 0; s2 <= t; ++s2) o += sA[t * 4 + s2] * sV[s2 * 128 + v];
      const float ss = wave_sum(o * o);
      if (lane == 0) sSS[wave] = ss;
      __syncthreads();
      const float tot = sSS[2 * t] + sSS[2 * t + 1];
      const float r = 1.0f / sqrtf(tot * (1.0f / HD) + EPS);
      X[(size_t)(row0 + t) * DM + hc + v] = f2bf1(o * r * c.hgrn_nw[l * HD + v] * sZ[t * 128 + v]); }
    __syncthreads();
}


typedef short bf16x8 __attribute__((ext_vector_type(8)));
typedef float f32x16 __attribute__((ext_vector_type(16)));
typedef float f32x2_t __attribute__((ext_vector_type(2))); typedef __bf16 bf16x2_t __attribute__((ext_vector_type(2)));
DI unsigned cvtpk(float lo, float hi) { f32x2_t v = {lo, hi}; bf16x2_t b = __builtin_convertvector(v, bf16x2_t); return __builtin_bit_cast(unsigned, b); }
DI int crow(int reg, int h) { return (reg & 3) + 8 * (reg >> 2) + 4 * h; }
constexpr int NCH = 33, NCI = BATCH * NH * NCH;
constexpr size_t WS_QT = 512 * MiB, WS_KHT = 529 * MiB, WS_VT = 546 * MiB, WS_AM = 563 * MiB, WS_DG = 572 * MiB, WS_ENDQ = 573 * MiB, WS_END2 = 600 * MiB;
static_assert(WS_MIXP >= WS_ENDQ && WS_MIXP + 4 * (size_t)XROWS * DM * 2 <= WS_END2, "partials map");
static_assert(WS_END <= WS_QT && (size_t)NCI * 64 * 128 * 2 <= 17 * MiB && (size_t)NCI * 64 * 64 * 2 <= 9 * MiB && (size_t)NCI * 128 * 4 <= MiB, "chunk operand map");
constexpr int CW_FLAG = 16384, FLAG_STRIDE = 16;
#define RLX_AGENT __ATOMIC_RELAXED, __HIP_MEMORY_SCOPE_AGENT
DI __amdgpu_buffer_rsrc_t mk_rsrc(unsigned char* p, unsigned bytes) { return __builtin_amdgcn_make_buffer_rsrc((void*)p, (short)0, (int)bytes, 0x00020000); }
constexpr unsigned RS_ALL = (unsigned)(WS_ENDQ - WS_QT), RO_KH = (unsigned)(WS_KHT - WS_QT), RO_VT = (unsigned)(WS_VT - WS_QT), RO_AM = (unsigned)(WS_AM - WS_QT), RO_DG = (unsigned)(WS_DG - WS_QT);
DI void st_sc1(__amdgpu_buffer_rsrc_t r, unsigned byte_off, v4u v) { __builtin_amdgcn_raw_buffer_store_b128(v, r, (int)byte_off, 0, 16); }
DI v4u ld_sc1(__amdgpu_buffer_rsrc_t r, unsigned byte_off) { return __builtin_amdgcn_raw_buffer_load_b128(r, (int)byte_off, 0, 16); }

DI void chunk_prep_item(const Ctx& c, int ci, unsigned epoch) {
    const Tid t_ = get_tid(); const int tid = t_.tid, lane = t_.lane, wave = t_.wave;
    const int bh = ci / NCH, cidx = ci - bh * NCH, b = bh >> 3, h = bh & 7, hc = h * HD;
    LAS float* sG = (LAS float*)c.lds;
    LAS unsigned short* sQb = (LAS unsigned short*)(c.lds + 33792);
    LAS unsigned short* sKb = sQb + 64 * 136;
    LAS unsigned short* sVb = sKb + 64 * 136;
    LAS float* sTot = (LAS float*)(c.lds + 33792 + 3 * 17408);
    LAS unsigned short* sA = (LAS unsigned short*)(c.lds + 33792 + 3 * 17408 + 2048);
    LAS unsigned short* sQx = sA + 4096;
    LAS unsigned short* sKx = sQx + 136 * 136;
    const bf16* Q = (const bf16*)(c.ws + WS_Q); const bf16* K1 = (const bf16*)(c.ws + WS_K1); const bf16* V = (const bf16*)(c.ws + WS_V); const float* G = (const float*)(c.ws + WS_G);
    const __amdgpu_buffer_rsrc_t rOP = mk_rsrc(c.ws + WS_QT, RS_ALL);
#define PSTAMP(i)
    { const int t = tid >> 3, c16 = (tid & 7) * 16;
      bool valid = true; int row;
      if (cidx == 0) { valid = t >= 48; row = ROW_M0 + b * NMETA + (t - 48); } else row = b * SEQ + 64 * (cidx - 1) + t;
      v4u q0 = {0u, 0u, 0u, 0u}, q1 = q0, k0 = q0, k1 = q0, v0 = q0, v1 = q0; f32x4 g0 = {0.f, 0.f, 0.f, 0.f}, g1 = g0, g2 = g0, g3 = g0;
      if (valid) { const size_t o = (size_t)row * WA + hc + c16;
          q0 = *(const v4u*)(Q + o); q1 = *(const v4u*)(Q + o + 8); k0 = *(const v4u*)(K1 + o); k1 = *(const v4u*)(K1 + o + 8); v0 = *(const v4u*)(V + o); v1 = *(const v4u*)(V + o + 8);
          g0 = *(const f32x4*)(G + o); g1 = *(const f32x4*)(G + o + 4); g2 = *(const f32x4*)(G + o + 8); g3 = *(const f32x4*)(G + o + 12); }
      *(LAS v4u*)(sQb + t * 136 + c16) = q0; *(LAS v4u*)(sQb + t * 136 + c16 + 8) = q1;
      *(LAS v4u*)(sKb + t * 136 + c16) = k0; *(LAS v4u*)(sKb + t * 136 + c16 + 8) = k1;
      *(LAS v4u*)(sVb + t * 136 + c16) = v0; *(LAS v4u*)(sVb + t * 136 + c16 + 8) = v1;
      *(LAS f32x4*)(sG + t * 132 + c16) = g0; *(LAS f32x4*)(sG + t * 132 + c16 + 4) = g1; *(LAS f32x4*)(sG + t * 132 + c16 + 8) = g2; *(LAS f32x4*)(sG + t * 132 + c16 + 12) = g3;
      *(LAS v4u*)(sA + tid * 8) = (v4u){0u, 0u, 0u, 0u}; }
    __syncthreads(); PSTAMP(1);
    { const int k = tid & 127, seg = tid >> 7; float run = 0.f;
#pragma unroll
      for (int i = 0; i < 16; ++i) { const int idx = (16 * seg + i) * 132 + k; run += sG[idx]; sG[idx] = run; }
      sTot[seg * 128 + k] = run; }
    __syncthreads();
    { const int k = tid & 127, seg = tid >> 7; float off = 0.f;
      for (int s = 0; s < seg; ++s) off += sTot[s * 128 + k];
      if (seg > 0) {
#pragma unroll
          for (int i = 0; i < 16; ++i) sG[(16 * seg + i) * 132 + k] += off; } }
    __syncthreads(); PSTAMP(2);
    { const int t = tid >> 3, gi = tid & 7; float qv[16];
      unpack8(*(const LAS v4u*)(sQb + t * 136 + 16 * gi), qv); unpack8(*(const LAS v4u*)(sQb + t * 136 + 16 * gi + 8), qv + 8);
      float e[16];
#pragma unroll
      for (int j4 = 0; j4 < 4; ++j4) { const f32x4 gg = *(const LAS f32x4*)(sG + t * 132 + 16 * gi + 4 * j4);
#pragma unroll
          for (int x = 0; x < 4; ++x) e[4 * j4 + x] = qv[4 * j4 + x] * __expf(gg[x]); }
      v4u w0, w1;
      w0.x = cvtpk(e[0], e[1]); w0.y = cvtpk(e[2], e[3]); w0.z = cvtpk(e[8], e[9]); w0.w = cvtpk(e[10], e[11]);
      w1.x = cvtpk(e[4], e[5]); w1.y = cvtpk(e[6], e[7]); w1.z = cvtpk(e[12], e[13]); w1.w = cvtpk(e[14], e[15]);
      const unsigned dst = (unsigned)(((ci * 64 + t) * 128 + 16 * gi) * 2);
      st_sc1(rOP, dst, w0); st_sc1(rOP, dst + 16, w1);
      if (tid < 32) { const f32x4 gg = *(const LAS f32x4*)(sG + 63 * 132 + 4 * tid); v4u d; d.x = __float_as_uint(__expf(gg.x)); d.y = __float_as_uint(__expf(gg.y)); d.z = __float_as_uint(__expf(gg.z)); d.w = __float_as_uint(__expf(gg.w));
          st_sc1(rOP, RO_DG + (unsigned)((ci * 128 + 4 * tid) * 4), d); } }
    PSTAMP(6);
    { const int k = tid & 127, sg = tid >> 7; const float gl = sG[63 * 132 + k]; float e[16], vv[16];
#pragma unroll
      for (int j = 0; j < 16; ++j) { const int s = 16 * sg + j; e[j] = bf2f(sKb[s * 136 + k]) * __expf(gl - sG[s * 132 + k]); vv[j] = bf2f(sVb[s * 136 + k]); }
      v4u w0, w1;
      w0.x = cvtpk(e[0], e[1]); w0.y = cvtpk(e[2], e[3]); w0.z = cvtpk(e[4], e[5]); w0.w = cvtpk(e[6], e[7]);
      w1.x = cvtpk(e[8], e[9]); w1.y = cvtpk(e[10], e[11]); w1.z = cvtpk(e[12], e[13]); w1.w = cvtpk(e[14], e[15]);
      LAS unsigned char* stK = (LAS unsigned char*)sQx; LAS unsigned char* stV = stK + 128 * 144;
      *(LAS v4u*)(stK + k * 144 + 32 * sg) = w0; *(LAS v4u*)(stK + k * 144 + 32 * sg + 16) = w1;
      w0.x = cvtpk(vv[0], vv[1]); w0.y = cvtpk(vv[2], vv[3]); w0.z = cvtpk(vv[4], vv[5]); w0.w = cvtpk(vv[6], vv[7]);
      w1.x = cvtpk(vv[8], vv[9]); w1.y = cvtpk(vv[10], vv[11]); w1.z = cvtpk(vv[12], vv[13]); w1.w = cvtpk(vv[14], vv[15]);
      *(LAS v4u*)(stV + k * 144 + 32 * sg) = w0; *(LAS v4u*)(stV + k * 144 + 32 * sg + 16) = w1;
      __syncthreads();
#pragma unroll
      for (int i = 0; i < 2; ++i) { const int p = tid + NTHR * i; const unsigned go = (unsigned)((ci * 1024 + p) * 16);
          st_sc1(rOP, RO_KH + go, *(const LAS v4u*)(stK + (p >> 3) * 144 + (p & 7) * 16)); st_sc1(rOP, RO_VT + go, *(const LAS v4u*)(stV + (p >> 3) * 144 + (p & 7) * 16)); }
      __syncthreads(); }
    PSTAMP(7);
#pragma unroll 7
    for (int task = tid; task < 208 * 16; task += NTHR) {
        const int rowx = task >> 4, kg = (task & 15) * 8;
        int t, rf; bool isq = rowx < 128;
        if (rowx < 96) { const int j = rowx < 48 ? 0 : (rowx < 80 ? 1 : 2); t = rowx < 48 ? 16 + rowx : (rowx < 80 ? rowx - 16 : rowx - 32); rf = 16 * j + 15; }
        else if (rowx < 128) { const int bb = (rowx - 96) >> 3, i = (rowx - 96) & 7; t = 16 * bb + 8 + i; rf = 16 * bb + 7; }
        else if (rowx < 176) { t = rowx - 128; rf = (t & ~15) + 15; }
        else { const int bb = (rowx - 176) >> 3, i = (rowx - 176) & 7; t = 16 * bb + i; rf = 16 * bb + 7; }
        float xv[8]; unpack8(*(const LAS v4u*)((isq ? sQb : sKb) + t * 136 + kg), xv);
        const f32x4 a0 = *(const LAS f32x4*)(sG + t * 132 + kg), a1 = *(const LAS f32x4*)(sG + t * 132 + kg + 4);
        const f32x4 r0 = *(const LAS f32x4*)(sG + rf * 132 + kg), r1 = *(const LAS f32x4*)(sG + rf * 132 + kg + 4);
        const float sgn = isq ? 1.0f : -1.0f; float e[8];
#pragma unroll
        for (int x = 0; x < 4; ++x) { e[x] = xv[x] * __expf(sgn * (a0[x] - r0[x])); e[4 + x] = xv[4 + x] * __expf(sgn * (a1[x] - r1[x])); }
        v4u w; w.x = cvtpk(e[0], e[1]); w.y = cvtpk(e[2], e[3]); w.z = cvtpk(e[4], e[5]); w.w = cvtpk(e[6], e[7]);
        *(LAS v4u*)((isq ? sQx + rowx * 136 : sKx + (rowx - 128) * 136) + kg) = w;
    }
    __syncthreads(); PSTAMP(3);
    for (int tile = wave; tile < 10; tile += NWAVES) {
        const int fr = lane & 15, fq = lane >> 4;
        int qrow, krow_, orow, ocol; bool small = tile >= 6;
        if (!small) { const int bi = tile < 3 ? tile + 1 : (tile < 5 ? tile - 1 : 3), bj = tile < 3 ? 0 : (tile < 5 ? 1 : 2);
            qrow = (bj == 0 ? 0 : (bj == 1 ? 48 : 80)) + 16 * (bi - bj - 1); krow_ = 16 * bj; orow = 16 * bi; ocol = 16 * bj; }
        else { const int bb = tile - 6; qrow = 96 + 8 * bb; krow_ = 48 + 8 * bb; orow = 16 * bb + 8; ocol = 16 * bb; }
        f32x4 acc = {0.f, 0.f, 0.f, 0.f};
#pragma unroll
        for (int ks = 0; ks < 4; ++ks) {
            const bf16x8 a = *(const LAS bf16x8*)(sQx + (qrow + fr) * 136 + 32 * ks + 8 * fq);
            const bf16x8 bb = *(const LAS bf16x8*)(sKx + (krow_ + fr) * 136 + 32 * ks + 8 * fq);
            acc = __builtin_amdgcn_mfma_f32_16x16x32_bf16(a, bb, acc, 0, 0, 0); }
        if (!small) {
#pragma unroll
            for (int i = 0; i < 4; ++i) sA[(orow + 4 * fq + i) * 64 + ocol + fr] = (unsigned short)(cvtpk(acc[i], 0.f) & 0xffffu); }
        else if (fq < 2 && fr < 8) {
#pragma unroll
            for (int i = 0; i < 4; ++i) sA[(orow + 4 * fq + i) * 64 + ocol + fr] = (unsigned short)(cvtpk(acc[i], 0.f) & 0xffffu); }
    }
    PSTAMP(8);
    { const int kp = tid & 15, grp = tid >> 4, blk = grp >> 2, tp = grp & 3, t0 = 8 * blk + tp, t1 = 8 * blk + 7 - tp;
      v2u q0[2], q1[2]; f32x4 g0[2], g1[2];
#pragma unroll
      for (int hf = 0; hf < 2; ++hf) { const int k4 = 64 * hf + 4 * kp;
          q0[hf] = *(const LAS v2u*)(sQb + t0 * 136 + k4); g0[hf] = *(const LAS f32x4*)(sG + t0 * 132 + k4);
          q1[hf] = *(const LAS v2u*)(sQb + t1 * 136 + k4); g1[hf] = *(const LAS f32x4*)(sG + t1 * 132 + k4); }
#pragma unroll 3
      for (int i = 0; i < 9; ++i) {
          const bool fst = i <= tp; const int t = fst ? t0 : t1, s = 8 * blk + (fst ? i : i - tp - 1);
          float a = 0.f;
#pragma unroll
          for (int hf = 0; hf < 2; ++hf) { const int k4 = 64 * hf + 4 * kp;
              const v2u qw = fst ? q0[hf] : q1[hf], kw = *(const LAS v2u*)(sKb + s * 136 + k4);
              const f32x4 gt = fst ? g0[hf] : g1[hf], gs = *(const LAS f32x4*)(sG + s * 132 + k4);
              a += bflo(qw.x) * bflo(kw.x) * __expf(gt.x - gs.x); a += bfhi(qw.x) * bfhi(kw.x) * __expf(gt.y - gs.y);
              a += bflo(qw.y) * bflo(kw.y) * __expf(gt.z - gs.z); a += bfhi(qw.y) * bfhi(kw.y) * __expf(gt.w - gs.w); }
          a = row16_sum(a);
          if (kp == 0) sA[t * 64 + s] = (unsigned short)(cvtpk(a, 0.f) & 0xffffu);
      } }
    __syncthreads(); PSTAMP(4);
    st_sc1(rOP, RO_AM + (unsigned)((ci * 4096 + tid * 8) * 2), *(const LAS v4u*)(sA + tid * 8));
    asm volatile("s_waitcnt vmcnt(0)" ::: "memory");
    __syncthreads();
    if (tid == 0) __hip_atomic_store((unsigned*)(c.ws + WS_CTL) + CW_FLAG + ci * FLAG_STRIDE, epoch, RLX_AGENT);
}

DI bool wait_flag(unsigned* flag, unsigned want, unsigned* tmo) {
    for (unsigned spins = 0;;) {
        if ((unsigned)__builtin_amdgcn_readfirstlane(__hip_atomic_load(flag, RLX_AGENT)) >= want) return true;
        __builtin_amdgcn_s_sleep(2);
        if (++spins > (1u << 22)) { __hip_atomic_store(tmo, 1u, RLX_AGENT); return false; }
    }
}
DI int ensure_ready(unsigned* flags0, int cc, int ready_upto, unsigned epoch, unsigned* tmo, int lane) {
    unsigned spins = 0;
    while (ready_upto < cc) {
        const int cq = ready_upto + 1 + (lane & 15);
        const unsigned v = cq < NCH ? __hip_atomic_load(flags0 + cq * FLAG_STRIDE, RLX_AGENT) : epoch;
        const unsigned m = (unsigned)(__ballot(v >= epoch) & 0xffffull);
        const int n = __builtin_ctz(~m | 0x10000u);
        if (n > 0) ready_upto += n;
        else { __builtin_amdgcn_s_sleep(2); if (++spins > (1u << 22)) { __hip_atomic_store(tmo, 1u, RLX_AGENT); return cc; } }
    }
    return ready_upto;
}
DI void hgrn_scan(const Ctx& c, int l, int bh) {
    const Tid t_ = get_tid(); const int tid = t_.tid, lane = t_.lane, wave = t_.wave;
    const int b = bh >> 3, h = bh & 7, hc = h * HD;
    constexpr int OB = 64000, O_KH = 17408, O_VT = 35840, O_AM = 54272, O_D = 63488, OO = 2 * OB, OOB = 64 * 272;
    LAS float* sNW = (LAS float*)(c.lds + OO + 2 * OOB);
    if (tid < HD) sNW[tid] = c.hgrn_nw[l * HD + tid];
    const bf16* ZA = (const bf16*)(c.ws + WS_ZA); bf16* X = (bf16*)(c.ws + WS_X);
    const int nrow = tid >> 4, vg = tid & 15;
    v4u pz[2];
#define SCAN_LOAD_ZA(cc) do { if ((cc) < NCH) { _Pragma("unroll") for (int i = 0; i < 2; ++i) { \
            const int rr_ = nrow + 32 * i; const int grow_ = (cc) == 0 ? ROW_M0 + b * NMETA + rr_ - 48 : b * SEQ + 64 * ((cc) - 1) + rr_; \
            pz[i] = ((cc) == 0 && rr_ < 48) ? (v4u){0u, 0u, 0u, 0u} : *(const v4u*)(ZA + (size_t)grow_ * WA + hc + 8 * vg); } } } while (0)
#define SCAN_NORM(cc) do { if ((cc) >= 0) { const LAS unsigned char* so_ = c.lds + OO + ((cc) & 1) * OOB; _Pragma("unroll") for (int i = 0; i < 2; ++i) { const int rr = nrow + 32 * i; \
            float o[8]; unpack8(*(const LAS v4u*)(so_ + rr * 272 + vg * 16), o); \
            float ss = (o[0] * o[0] + o[1] * o[1]) + (o[2] * o[2] + o[3] * o[3]) + (o[4] * o[4] + o[5] * o[5]) + (o[6] * o[6] + o[7] * o[7]); \
            ss = row16_sum(ss); \
            const float rs = __builtin_amdgcn_rsqf(ss * (1.0f / HD) + EPS); \
            float z[8]; unpack8(pz[i], z); const f32x4 n0 = *(const LAS f32x4*)(sNW + 8 * vg), n1 = *(const LAS f32x4*)(sNW + 8 * vg + 4); \
            v4u w; w.x = cvtpk(o[0] * rs * n0.x * z[0], o[1] * rs * n0.y * z[1]); w.y = cvtpk(o[2] * rs * n0.z * z[2], o[3] * rs * n0.w * z[3]); \
            w.z = cvtpk(o[4] * rs * n1.x * z[4], o[5] * rs * n1.y * z[5]); w.w = cvtpk(o[6] * rs * n1.z * z[6], o[7] * rs * n1.w * z[7]); \
            if ((cc) > 0 || rr >= 48) { const int grow = (cc) == 0 ? ROW_M0 + b * NMETA + rr - 48 : b * SEQ + 64 * ((cc) - 1) + rr; \
                *(v4u*)(X + (size_t)grow * DM + hc + 8 * vg) = w; } \
            asm volatile("" ::: "memory"); } } } while (0)
    if (wave >= 4) {
        const __amdgpu_buffer_rsrc_t rOP = mk_rsrc(c.ws + WS_QT, RS_ALL);
        unsigned* flags = (unsigned*)(c.ws + WS_CTL) + CW_FLAG; unsigned* tmo = (unsigned*)(c.ws + WS_CTL) + 8;
        const unsigned epoch = (unsigned)l + 1u;
        const int lt0 = tid - 256;
        v4u aq[4], ak[4], av[4], aa[2], ad, bq[4], bk[4], bv[4], ba[2], bd, cq[4], ck[4], cv[4], ca[2], cd;
        int ready_upto = -1;
#define PWAIT_BEGIN
#define PWAIT_END
#define SCAN_ISSUE(cc, Q_, K_, V_, A_, D_) do { if ((cc) < NCH) { const int ci_ = bh * NCH + (cc); int lt = lt0; asm volatile("" : "+v"(lt)); \
            PWAIT_BEGIN; ready_upto = ensure_ready(flags + bh * NCH * FLAG_STRIDE, (cc), ready_upto, epoch, tmo, lane); PWAIT_END; \
            _Pragma("unroll") for (int i = 0; i < 4; ++i) { const unsigned o_ = (unsigned)((ci_ * 1024 + lt + 256 * i) * 16); Q_[i] = ld_sc1(rOP, o_); K_[i] = ld_sc1(rOP, RO_KH + o_); V_[i] = ld_sc1(rOP, RO_VT + o_); } \
            _Pragma("unroll") for (int i = 0; i < 2; ++i) A_[i] = ld_sc1(rOP, RO_AM + (unsigned)((ci_ * 512 + lt + 256 * i) * 16)); \
            D_ = lt < 32 ? ld_sc1(rOP, RO_DG + (unsigned)((ci_ * 32 + lt) * 16)) : (v4u){0u, 0u, 0u, 0u}; } } while (0)
#define SCAN_STAGE(cc, Q_, K_, V_, A_, D_) do { if ((cc) < NCH) { LAS unsigned char* ob_ = c.lds + ((cc) & 1) * OB; int lt = lt0; asm volatile("" : "+v"(lt));     \
            _Pragma("unroll") for (int i = 0; i < 4; ++i) { const int p = lt + 256 * i; \
                *(LAS v4u*)(ob_ + (p >> 4) * 272 + (p & 15) * 16) = Q_[i]; \
                *(LAS v4u*)(ob_ + O_KH + (p >> 3) * 144 + (p & 7) * 16) = K_[i]; \
                *(LAS v4u*)(ob_ + O_VT + (p >> 3) * 144 + (p & 7) * 16) = V_[i]; } \
            _Pragma("unroll") for (int i = 0; i < 2; ++i) { const int p = lt + 256 * i; *(LAS v4u*)(ob_ + O_AM + (p >> 3) * 144 + (p & 7) * 16) = A_[i]; } \
            if (lt < 32) *(LAS v4u*)(ob_ + O_D + lt * 16) = D_; } } while (0)
#define SCAN_STEP(cc, Q_, K_, V_, A_, D_) do { if ((cc) < NCH) { \
            SCAN_NORM((cc) - 1); SCAN_LOAD_ZA(cc); \
            SCAN_STAGE((cc) + 1, Q_, K_, V_, A_, D_); SCAN_ISSUE((cc) + 4, Q_, K_, V_, A_, D_); \
            __syncthreads(); } } while (0)
        SCAN_ISSUE(0, aq, ak, av, aa, ad); SCAN_ISSUE(1, bq, bk, bv, ba, bd); SCAN_ISSUE(2, cq, ck, cv, ca, cd);
        SCAN_STAGE(0, aq, ak, av, aa, ad); SCAN_ISSUE(3, aq, ak, av, aa, ad);
        __syncthreads();
#pragma unroll 1
        for (int cc = 0; cc < NCH; cc += 3) {
            SCAN_STEP(cc, bq, bk, bv, ba, bd);
            SCAN_STEP(cc + 1, cq, ck, cv, ca, cd);
            SCAN_STEP(cc + 2, aq, ak, av, aa, ad);
        }
        SCAN_NORM(NCH - 1);
#undef SCAN_STEP
#undef SCAN_ISSUE
#undef SCAN_STAGE
    } else {
        __builtin_amdgcn_s_setprio(1);
        const int r = lane & 31, hh = lane >> 5, vs = wave;
        f32x16 S[4];
#pragma unroll
        for (int kt = 0; kt < 4; ++kt)
#pragma unroll
            for (int i = 0; i < 16; ++i) S[kt][i] = 0.f;
        __syncthreads();
#pragma unroll 1
        for (int cc = 0; cc < NCH; ++cc) {
            SCAN_NORM(cc - 1); SCAN_LOAD_ZA(cc);
            LAS unsigned short* sO = (LAS unsigned short*)(c.lds + OO + (cc & 1) * OOB) + 32 * vs + r;
            LAS unsigned char* sQT = c.lds + (cc & 1) * OB; LAS unsigned char* sKH = sQT + O_KH; LAS unsigned char* sVT = sQT + O_VT; LAS unsigned char* sAM = sQT + O_AM; LAS float* sD = (LAS float*)(sQT + O_D);
            const LAS unsigned char* pAM = sAM + r * 144 + hh * 16; const LAS unsigned char* pQT = sQT + r * 272 + hh * 16; const LAS unsigned char* pKH = sKH + r * 144 + hh * 16;
#define LDSW() do { asm volatile("s_waitcnt lgkmcnt(0)" ::: "memory"); __builtin_amdgcn_sched_barrier(0); } while (0)
#define LDF(p) (*(const LAS bf16x8*)(p))
#define LDD(dst, kt) do { _Pragma("unroll") for (int g = 0; g < 4; ++g) dst[g] = *(const LAS f32x4*)(sD + 32 * (kt) + 8 * g + 4 * hh); } while (0)
#define SCALE(kt, dsrc) do { _Pragma("unroll") for (int g = 0; g < 4; ++g) _Pragma("unroll") for (int e = 0; e < 4; ++e) S[kt][4 * g + e] *= dsrc[g][e]; } while (0)
#define MF(a, b, c) __builtin_amdgcn_mfma_f32_32x32x16_bf16((a), (b), (c), 0, 0, 0)
#define LD4(dst, p) do { _Pragma("unroll") for (int i = 0; i < 4; ++i) dst[i] = LDF((p) + 32 * i); } while (0)
#define WRO(ov, rbase) do { _Pragma("unroll") for (int i = 0; i < 16; i += 2) { const unsigned w_ = cvtpk(ov[i], ov[i + 1]); sO[((rbase) + crow(i, hh)) * 136] = (unsigned short)(w_ & 0xffffu); sO[((rbase) + crow(i + 1, hh)) * 136] = (unsigned short)(w_ >> 16); } } while (0)
            bf16x8 vf[4], fa[4], fb[4]; f32x4 dd[4];
#pragma unroll
            for (int ss = 0; ss < 4; ++ss) vf[ss] = LDF(sVT + (32 * vs + r) * 144 + (16 * ss + 8 * hh) * 2);
            LD4(fa, pAM);
            bf16x8 sb[8];
#pragma unroll
            for (int ks = 0; ks < 8; ++ks) { const int kt = ks >> 1, s8 = (ks & 1) * 8; v4u w;
                w.x = cvtpk(S[kt][s8 + 0], S[kt][s8 + 1]); w.y = cvtpk(S[kt][s8 + 2], S[kt][s8 + 3]); w.z = cvtpk(S[kt][s8 + 4], S[kt][s8 + 5]); w.w = cvtpk(S[kt][s8 + 6], S[kt][s8 + 7]);
                sb[ks] = __builtin_bit_cast(bf16x8, w); }
            LDSW();
            LD4(fb, pQT);
            f32x16 o0;
#pragma unroll
            for (int i = 0; i < 16; ++i) o0[i] = 0.f;
#pragma unroll
            for (int i = 0; i < 4; ++i) o0 = MF(fa[i], vf[i], o0);
            LDSW();
            LD4(fa, pQT + 128);
#pragma unroll
            for (int i = 0; i < 4; ++i) o0 = MF(fb[i], sb[i], o0);
            LDSW();
            LD4(fb, pAM + 32 * 144);
#pragma unroll
            for (int i = 0; i < 4; ++i) o0 = MF(fa[i], sb[4 + i], o0);
            WRO(o0, 0);
            LDSW();
            LD4(fa, pQT + 32 * 272);
            f32x16 o1;
#pragma unroll
            for (int i = 0; i < 16; ++i) o1[i] = 0.f;
#pragma unroll
            for (int i = 0; i < 4; ++i) o1 = MF(fb[i], vf[i], o1);
            LDSW();
            LD4(fb, pQT + 32 * 272 + 128);
#pragma unroll
            for (int i = 0; i < 4; ++i) o1 = MF(fa[i], sb[i], o1);
            LDSW();
            LD4(fa, pKH); LDD(dd, 0);
#pragma unroll
            for (int i = 0; i < 4; ++i) o1 = MF(fb[i], sb[4 + i], o1);
            WRO(o1, 32);
            LDSW();
            SCALE(0, dd);
            LD4(fb, pKH + 32 * 144); LDD(dd, 1);
#pragma unroll
            for (int i = 0; i < 4; ++i) S[0] = MF(fa[i], vf[i], S[0]);
            LDSW();
            SCALE(1, dd);
            LD4(fa, pKH + 64 * 144); LDD(dd, 2);
#pragma unroll
            for (int i = 0; i < 4; ++i) S[1] = MF(fb[i], vf[i], S[1]);
            LDSW();
            SCALE(2, dd);
            LD4(fb, pKH + 96 * 144); LDD(dd, 3);
#pragma unroll
            for (int i = 0; i < 4; ++i) S[2] = MF(fa[i], vf[i], S[2]);
            LDSW();
            SCALE(3, dd);
#pragma unroll
            for (int i = 0; i < 4; ++i) S[3] = MF(fb[i], vf[i], S[3]);
#undef LD4
#undef WRO
#undef LDSW
#undef LDF
#undef LDD
#undef SCALE
#undef MF
            __syncthreads();
        }
        SCAN_NORM(NCH - 1);
        float* So = c.out + O_SHP + (((size_t)l * BATCH + b) * NH + h) * (size_t)(HD * HD);
#pragma unroll
        for (int kt = 0; kt < 4; ++kt)
#pragma unroll
            for (int i = 0; i < 16; ++i) So[(size_t)(32 * kt + crow(i, hh)) * HD + 32 * vs + r] = S[kt][i];
        __builtin_amdgcn_s_setprio(0);
    }
#undef SCAN_LOAD_ZA
#undef SCAN_NORM
    __syncthreads();
}

struct OneUnit { int pm, pn;
    __device__ __forceinline__ bool next(int i, pg8::Unit& u) const { if (i) return false; u.pm = pm; u.pn = pn; return true; }
    __device__ __forceinline__ void a_ready(const pg8::Unit&) const {}
    __device__ __forceinline__ void done(const pg8::Unit&) const {} };
DI void publish_count(unsigned* word) {
    asm volatile("s_waitcnt vmcnt(0)" ::: "memory");
    __syncthreads();
    if (threadIdx.x == 0) __hip_atomic_fetch_add(word, 1u, RLX_AGENT);
}
DI void wait_count_acquire(unsigned* word, unsigned need, unsigned* tmo) {
    if (threadIdx.x < 64) { wait_flag(word, need, tmo); __builtin_amdgcn_fence(__ATOMIC_ACQUIRE, "agent"); asm volatile("s_waitcnt vmcnt(0)" ::: "memory"); }
    __syncthreads();
}
constexpr int CW_QUEUE = 2048;
constexpr int QI_ILV = 8, SCAN_OWN = 2;
constexpr int QI_CHUNK = NCI, QI_SAMPLE = DECB * NH, QI_CONVX = (M_ROWS - ROW_S0 + 31) / 32, QI_CONV = QI_CONVX + 16  , QI_DEFER = 96, QI_HEAD = 7 * (32 + QI_ILV);
constexpr int CW_DEFER = 9216;
static_assert(PREP_ITEMS % 16 == 0 && PREP_I_OUT % 16 == 0 && PREP_I_IN % 16 == 0, "prep items");
struct QPop { unsigned* qword; volatile LAS unsigned* slot; unsigned pending; int it; };
DI QPop q_begin(unsigned* qword, volatile LAS unsigned* slot) { QPop q; q.qword = qword; q.slot = slot; q.it = 0; q.pending = 0u;
    if (threadIdx.x == 0) q.pending = __hip_atomic_fetch_add(qword, 1u, RLX_AGENT); return q; }
DI int q_next(QPop& q) {
    volatile LAS unsigned* sl = q.slot + (q.it & 1); q.it ^= 1;
    if (threadIdx.x == 0) *sl = q.pending;
    __syncthreads();
    const int idx = __builtin_amdgcn_readfirstlane((int)*sl);
    if (threadIdx.x == 0) q.pending = __hip_atomic_fetch_add(q.qword, 1u, RLX_AGENT);
    return idx;
}
constexpr unsigned Q_NONE = 0xffffffffu;
DI QPop q_begin_hold(unsigned* qword, volatile LAS unsigned* slot) { QPop q; q.qword = qword; q.slot = slot; q.it = 0; q.pending = Q_NONE; return q; }
DI int q_next_hold(QPop& q, int hold_lo, int hold_hi) {
    volatile LAS unsigned* sl = q.slot + (q.it & 1); q.it ^= 1;
    if (threadIdx.x == 0) *sl = q.pending != Q_NONE ? q.pending : __hip_atomic_fetch_add(q.qword, 1u, RLX_AGENT);
    __syncthreads();
    const int idx = __builtin_amdgcn_readfirstlane((int)*sl);
    if (threadIdx.x == 0) q.pending = (idx < hold_lo || idx >= hold_hi) ? __hip_atomic_fetch_add(q.qword, 1u, RLX_AGENT) : Q_NONE;
    return idx;
}
DI void phase_mixer(const Ctx& c, int l) {
    constexpr int NSCAN = BATCH * NH;
    const unsigned epoch = (unsigned)l + 1u;
    const int n_prep = (l + 1 < DEPTH ? PREP_ITEMS / 16 : 0), n_prep0 = (l == 0 ? PREP_I_OUT / 16 : 0);
    const int QI_P0 = QI_CHUNK + QI_SAMPLE, QI_C0 = QI_P0 + n_prep + n_prep0, QI_TOTAL = QI_C0 + QI_CONV;
    unsigned* qw = (unsigned*)(c.ws + WS_CTL) + CW_QUEUE + 16 * l;
    unsigned* du = (unsigned*)(c.ws + WS_CTL) + CW_DEFER; unsigned* tmo = (unsigned*)(c.ws + WS_CTL) + 8;
    bool have_du = false;
    volatile LAS unsigned* slot = (volatile LAS unsigned*)(c.lds + MISC_OFF) + 16;
    if (c.vcu < NSCAN) { for (int k = 0; k < SCAN_OWN; ++k) { chunk_prep_item(c, c.vcu * NCH + k, epoch); __syncthreads(); } hgrn_scan(c, l, c.vcu); }
    QPop qp = q_begin_hold(qw, slot);
    for (;;) {
        const int rawq = q_next_hold(qp, QI_HEAD, QI_HEAD + QI_DEFER);
        const int raw0 = rawq < QI_HEAD ? rawq + QI_DEFER : (rawq < QI_HEAD + QI_DEFER ? rawq - QI_HEAD : rawq);
        if (raw0 < QI_DEFER) {
            const pg8::Gemm g{(const pg8::bf16_t*)(c.ws + WS_HN), (const pg8::bf16_t*)(c.ws + WS_WIN) + (size_t)l * DIN * DM, M_PAD, DIN, DM, DM};
            const pg8::EpiInProj E{c.ws, l, 0};
            OneUnit O{29 + raw0 / 16, 16 + raw0 % 16};
            pg8::gemm_phase<pg8::EpiInProj, OneUnit, true, true>(c.lds, g, O, E);
            asm volatile("s_waitcnt vmcnt(0)" ::: "memory");
            __syncthreads();
            if (threadIdx.x == 0) { __builtin_amdgcn_fence(__ATOMIC_RELEASE, "agent"); __hip_atomic_fetch_add(du, 1u, RLX_AGENT); }
            continue; }
        const int raw = raw0 - QI_DEFER;
        int idx = raw;
        if (raw < (NCH - SCAN_OWN) * (32 + QI_ILV)) { const int blk = raw / (32 + QI_ILV), r_ = raw - blk * (32 + QI_ILV); idx = r_ < 32 ? (blk + SCAN_OWN) * 32 + r_ : QI_CHUNK + blk * QI_ILV + (r_ - 32); }
        else { const int r2 = raw - (NCH - SCAN_OWN) * (32 + QI_ILV);
            if (r2 < QI_CONV) idx = QI_C0 + r2;
            else if (r2 < QI_CONV + n_prep + n_prep0) idx = QI_P0 + (r2 - QI_CONV);
            else { idx = QI_CHUNK + (NCH - SCAN_OWN) * QI_ILV + (r2 - QI_CONV - n_prep - n_prep0); if (idx >= QI_P0) idx = QI_TOTAL; } }
        if (idx >= QI_TOTAL) break;
#ifndef REP_K
#define REP_K 1
#endif
#ifndef REP_S
#define REP_S 1
#endif
#ifndef REP_V
#define REP_V 1
#endif
        if (idx < QI_CHUNK) { const int cc = idx >> 5, bh = idx & 31; for (int rep = 0; rep < REP_K; ++rep) { chunk_prep_item(c, bh * NCH + cc, epoch); __syncthreads(); } }
        else if (idx < QI_CHUNK + QI_SAMPLE) { for (int rep = 0; rep < REP_S; ++rep) hgrn_sample_item(c, l, idx - QI_CHUNK); }
        else if (idx < QI_C0) { const int j = idx - QI_P0;
            if (j < n_prep) prep_layer(c, l + 1, j * 16, j * 16 + 16, NWAVES); else prep_layer(c, 0, PREP_I_IN + (j - n_prep) * 16, PREP_I_IN + (j - n_prep) * 16 + 16, NWAVES);
            __syncthreads(); }
        else { const int j = idx - QI_C0;
            if (!have_du) { wait_count_acquire(du, (unsigned)QI_DEFER * epoch, tmo); have_du = true; }
            if (j < QI_CONVX) phase_conv(c, l, ROW_S0 / 32 + j, 0); else phase_conv(c, l, j - QI_CONVX, -1); }
    }
}

constexpr int CW_CCNT = 3072;
constexpr int NB_ROWS = 16, QN_BLOCKS = M_ROWS / NB_ROWS, QN_EXTRA_UNITS = 3 * 8 * 4;
static_assert(M_ROWS % NB_ROWS == 0, "norm blocks");
DI void wait_main_counts_acquire(unsigned* ccnt, unsigned need, unsigned* tmo) {
    if (threadIdx.x < 64) { const int lane = threadIdx.x;
        for (unsigned spins = 0;;) { const unsigned v = lane < ROW_S0 / 256 ? __hip_atomic_load(ccnt + 16 * lane, RLX_AGENT) : need;
            if (__all(v >= need)) break;
            __builtin_amdgcn_s_sleep(2);
            if (++spins > (1u << 22)) { __hip_atomic_store(tmo, 1u, RLX_AGENT); break; } }
        __builtin_amdgcn_fence(__ATOMIC_ACQUIRE, "agent"); asm volatile("s_waitcnt vmcnt(0)" ::: "memory"); }
    __syncthreads();
}
DI void phase_outproj_norm(const Ctx& c, int l) {
    unsigned* ctl = (unsigned*)(c.ws + WS_CTL); unsigned* tmo = ctl + 8;
    const pg8::Gemm g{(const pg8::bf16_t*)(c.ws + WS_X), (const pg8::bf16_t*)(c.ws + WS_WOUT) + (size_t)l * DM * DM, M_PAD, DM, DM, DM};
    const pg8::EpiMix E{(pg8::bf16_t*)(c.ws + WS_MIX)};
    { pg8::StaticOrder S; S.init(ROW_S0, DM, c.G, (int)blockIdx.x);
      pg8::Unit u;
      for (int i = 0; S.next(i, u); ++i) { OneUnit O{u.pm, u.pn}; pg8::gemm_phase<pg8::EpiMix, OneUnit, true, true>(c.lds, g, O, E); publish_count(ctl + CW_CCNT + 16 * u.pm); } }
    unsigned* qw = ctl + CW_QUEUE + 16 * (DEPTH + l);
    volatile LAS unsigned* slot = (volatile LAS unsigned*)(c.lds + MISC_OFF) + 16;
    const unsigned need = 8u * (unsigned)(l + 1);
    int have = -1; bool have_main = false;
    QPop qp = q_begin(qw, slot);
    for (;;) {
        const int idx = q_next(qp);
        if (idx >= QN_EXTRA_UNITS + QN_BLOCKS) break;
        if (l == DEPTH - 1 && (idx < QN_EXTRA_UNITS ? (idx >> 2) / 8 == (ROW_M0 - ROW_S0) / 256 : (idx - QN_EXTRA_UNITS) * NB_ROWS >= ROW_M0)) continue;
        if (idx < QN_EXTRA_UNITS) {
            const int kq = idx & 3, un = idx >> 2; OneUnit O{ROW_S0 / 256 + un / 8, un % 8};
            const pg8::Gemm gq{g.A + kq * (DM / 4), g.Bt + kq * (DM / 4), M_PAD, DM, DM / 4, DM};
            const pg8::EpiMix Eq{(pg8::bf16_t*)(c.ws + WS_MIXP) + ((size_t)kq * XROWS - ROW_S0) * DM};
            pg8::gemm_phase<pg8::EpiMix, OneUnit, true, true>(c.lds, gq, O, Eq); publish_count(ctl + CW_CCNT + 16 * O.pm); }
        else { const int blk = idx - QN_EXTRA_UNITS, row0 = blk * NB_ROWS, mt = row0 >> 8;
            if (mt < ROW_S0 / 256) { if (!have_main) { wait_main_counts_acquire(ctl + CW_CCNT, need, tmo); have_main = true; } }
            else if (mt != have) { wait_count_acquire(ctl + CW_CCNT + 16 * mt, 4u * need, tmo); have = mt; }
#ifndef REP_N
#define REP_N 1
#endif
            for (int rep = 1; rep < REP_N; ++rep) norm_rows(c, l + 1, row0, row0 + NB_ROWS, NWAVES, true);
            norm_rows(c, l + 1, row0, row0 + NB_ROWS, NWAVES); }
    }
}
#ifndef REP_P
#define REP_P 1
#endif
#ifndef REP_A
#define REP_A 1
#endif
#ifndef REP_B1
#define REP_B1 1
#endif
#ifndef REP_B
#define REP_B 1
#endif
#ifndef REP_C
#define REP_C 1
#endif
struct DeferOrder { pg8::StaticOrder S;
    __device__ __forceinline__ bool next(int i, pg8::Unit& u) const { if (!S.next(i, u)) return false;
        if (i >= 2) u.pn ^= 16;
        if (u.pm >= 29 && u.pn >= 16) { u.pm += 3; u.pn -= 16; } return true; }
    __device__ __forceinline__ void a_ready(const pg8::Unit&) const {}
    __device__ __forceinline__ void done(const pg8::Unit&) const {} };
struct Args { const float* in[12]; float* out; unsigned char* ws; int ph_lo, ph_hi; };
constexpr int N_PHASES = 1 + 3 * DEPTH;
__global__ void __launch_bounds__(NTHR, 2) fwd(Args args) {
    extern __shared__ __attribute__((aligned(16))) unsigned char lds_raw[];
    Ctx c;
    c.lds = (LAS unsigned char*)lds_raw;
    c.G = gridDim.x; { const int bx = blockIdx.x; c.vcu = (c.G % 8 == 0) ? (bx % 8) * (c.G / 8) + bx / 8 : bx; }
    c.x_prompt = args.in[0]; c.x_sample = args.in[1]; c.state_hgrn = args.in[2]; c.state_conv = args.in[3]; c.meta = args.in[4]; c.w_in = args.in[5];
    c.conv_w = args.in[6]; c.lb_param = args.in[7]; c.hgrn_nw = args.in[8]; c.w_out = args.in[9]; c.pre_w = args.in[10]; c.post_w = args.in[11];
    c.out = args.out; c.ws = args.ws;
    volatile LAS unsigned* MISC = (volatile LAS unsigned*)(c.lds + MISC_OFF);
    if (threadIdx.x < 32) ((LAS unsigned*)(c.lds + MISC_OFF))[threadIdx.x] = 0u;
    __syncthreads();
    unsigned* barw = (unsigned*)(c.ws + WS_CTL) + CW_BAR;
    const bool multi = (args.ph_hi - args.ph_lo) > 1;
    XcdBarrier bar; bar.bar = barw; bar.x = 0; bar.st = nullptr;
    if (multi) bar = xcd_barrier_post(barw, MISC + 8);

    for (int ph = args.ph_lo; ph < args.ph_hi; ++ph) {
        if (ph > args.ph_lo) xcd_barrier(bar);
#ifdef REP_BAR
        if (ph == 2) for (int rep = 0; rep < REP_BAR; ++rep) xcd_barrier(bar);
#endif
        if (ph == 0) { for (int rep = 0; rep < REP_P; ++rep) phase_prep(c); phase_norm(c, 0); continue; }
        const int l = (ph - 1) / 3, k = (ph - 1) % 3;
        if (k == 0) { for (int rep = 0; rep < REP_A; ++rep) {
            pg8::Gemm g{(const pg8::bf16_t*)(c.ws + WS_HN), (const pg8::bf16_t*)(c.ws + WS_WIN) + (size_t)l * DIN * DM, M_PAD, DIN, DM, DM};
            DeferOrder S; S.S.init(ROW_S0, DIN, c.G, (int)blockIdx.x);
            pg8::EpiInProj E{c.ws, l, 0};
            pg8::gemm_phase<pg8::EpiInProj, DeferOrder, true, true>(c.lds, g, S, E); }
        } else if (k == 1) {
            phase_mixer(c, l);
        } else {
            phase_outproj_norm(c, l);
        }
    }
}

#ifndef MK_MULTI
#define MK_MULTI 0
#endif
extern "C" void kernel_launch(void* const* d_in, const int* in_sizes, int n_in, void* d_out, int out_size, void* d_ws, size_t ws_size, hipStream_t stream) {
    static int grid = 0;
    if (grid == 0) {
        if (n_in != 12 || (size_t)out_size != O_END || ws_size < WS_END2) { fprintf(stderr, "kernel_launch: unexpected shapes: n_in %d out %d ws %zu (need out %zu ws %zu)\n", n_in, out_size, ws_size, (size_t)O_END, (size_t)WS_END); grid = -1; return; }
        int dev = 0, cus = 0, per_cu = 0;
        if (hipGetDevice(&dev) != hipSuccess || hipDeviceGetAttribute(&cus, hipDeviceAttributeMultiprocessorCount, dev) != hipSuccess) { grid = -1; return; }
        if (hipFuncSetAttribute((const void*)fwd, hipFuncAttributeMaxDynamicSharedMemorySize, LDS_BYTES) != hipSuccess) { fprintf(stderr, "kernel_launch: hipFuncSetAttribute failed\n"); grid = -1; return; }
        if (hipOccupancyMaxActiveBlocksPerMultiprocessor(&per_cu, (const void*)fwd, NTHR, LDS_BYTES) != hipSuccess || per_cu < 1) { fprintf(stderr, "kernel_launch: occupancy query says %d blocks per CU\n", per_cu); (void)hipGetLastError(); per_cu = 1; }
        grid = cus;
    }
    if (grid < 0) return;
    (void)hipMemsetAsync((char*)d_ws + WS_CTL, 0, CTL_ZERO_BYTES, stream);
    Args a{};
    for (int i = 0; i < 12; ++i) a.in[i] = (const float*)d_in[i];
    a.out = (float*)d_out; a.ws = (unsigned char*)d_ws;
#if MK_MULTI
    for (int ph = 0; ph < N_PHASES; ++ph) {
        a.ph_lo = ph; a.ph_hi = ph + 1;
        hipLaunchKernelGGL(fwd, dim3(grid), dim3(NTHR), LDS_BYTES, stream, a);
    }
#else
    a.ph_lo = 0; a.ph_hi = N_PHASES;
    hipLaunchKernelGGL(fwd, dim3(grid), dim3(NTHR), LDS_BYTES, stream, a);
#endif
}
```
